# Optimizing an MI355X kernel written in HIP

```python
import math
import jax, jax.numpy as jnp
from jax import lax
import numpy as np

D_MODEL = 1024
BATCH = 16
SEQ = 2048
DEPTH = 1

CHUNK = 64
EPS = 1e-6
A_HEADS = 8
A_HEAD_DIM = 64
A_WIDTH = A_HEADS * A_HEAD_DIM
A_LATENT = 128
IDX_HEADS = 8
IDX_DIM = 64
TOPK_MAX = 256
Q_BLOCK = 128
REL_BUCKETS = 32
REL_MAX_DIST = 128
B_HEADS = 4
B_HEAD_DIM = 128
B_WIDTH = B_HEADS * B_HEAD_DIM
CONV_WIDTH = 4
D_MIX = A_WIDTH + B_WIDTH
D_FF = 4 * D_MODEL
_IN_SPLITS = (A_WIDTH, A_LATENT, IDX_HEADS * IDX_DIM, IDX_DIM, IDX_HEADS,
              B_WIDTH, B_WIDTH, B_WIDTH, B_HEADS, B_HEADS, B_WIDTH)
IN_COLS = sum(_IN_SPLITS)

kernel_name = 'hybrid_dsa_gdn_sandwich_block'


def rms_norm(x, g):
    xf = x.astype(jnp.float32)
    y = xf * lax.rsqrt(jnp.mean(xf * xf, axis=-1, keepdims=True) + EPS)
    return (y * g.astype(jnp.float32)).astype(x.dtype)


def l2_norm(x):
    xf = x.astype(jnp.float32)
    return xf * lax.rsqrt(jnp.sum(xf * xf, axis=-1, keepdims=True) + EPS)


def t5_bucket(rel):
    nb = REL_BUCKETS // 2
    max_exact = nb // 2
    side = jnp.where(rel > 0, nb, 0)
    n = jnp.abs(rel)
    nf = jnp.maximum(n, 1).astype(jnp.float32)
    large = max_exact + (jnp.log(nf / max_exact) / math.log(REL_MAX_DIST / max_exact)
                         * (nb - max_exact)).astype(jnp.int32)
    large = jnp.minimum(large, nb - 1)
    return side + jnp.where(n < max_exact, n, large)


def dsa_mixer(q_a, c_kv, q_idx, k_idx, w_idx, c_norm, w_uk, w_uv, rel_bias):
    B, T, _ = q_a.shape
    topk = min(TOPK_MAX, T // 4)
    nb = T // Q_BLOCK
    q = q_a.reshape(B, T, A_HEADS, A_HEAD_DIM)
    c = rms_norm(c_kv, c_norm)
    q_abs = jnp.einsum('bthd,hcd->bthc', q, w_uk) * (A_HEAD_DIM ** -0.5)
    qi = q_idx.reshape(B, T, IDX_HEADS, IDX_DIM) * (IDX_DIM ** -0.5)
    wi = w_idx * (IDX_HEADS ** -0.5)
    key_pos = jnp.arange(T)

    def blocks(a):
        return jnp.moveaxis(a.reshape(B, nb, Q_BLOCK, *a.shape[2:]), 1, 0)

    def one_block(args):
        blk, qa_b, qi_b, wi_b = args
        t = blk * Q_BLOCK + jnp.arange(Q_BLOCK)
        limit = (t // CHUNK + 1) * CHUNK
        rel = jax.nn.relu(jnp.einsum('bqhd,bsd->bqhs', qi_b, k_idx))
        score = jnp.einsum('bqhs,bqh->bqs', rel, wi_b).astype(jnp.float32)
        score = jnp.where(key_pos[None, None, :] < limit[None, :, None], score, -jnp.inf)
        _, idx = lax.top_k(score, topk)
        valid = idx < limit[None, :, None]
        c_sel = jax.vmap(lambda cb, ib: cb[ib])(c, idx)
        logits = jnp.einsum('bqhc,bqkc->bqkh', qa_b, c_sel).astype(jnp.float32)
        logits = logits + rel_bias[t5_bucket(idx - t[None, :, None])].astype(jnp.float32)
        logits = jnp.where(valid[..., None], logits, -jnp.inf)
        p = jax.nn.softmax(logits, axis=2).astype(c_sel.dtype)
        return jnp.einsum('bqkh,bqkc->bqhc', p, c_sel)

    o_lat = lax.map(one_block, (jnp.arange(nb), blocks(q_abs), blocks(qi), blocks(wi)))
    o_lat = jnp.moveaxis(o_lat, 0, 1).reshape(B, T, A_HEADS, A_LATENT)
    o = jnp.einsum('bthc,hcd->bthd', o_lat, w_uv)
    return o.reshape(B, T, A_WIDTH)


def causal_depthwise_conv(x, w):
    C = x.shape[-1]
    return lax.conv_general_dilated(x, w[:, None, :].astype(x.dtype), window_strides=(1,),
                                    padding=[(CONV_WIDTH - 1, 0)],
                                    dimension_numbers=('NWC', 'WIO', 'NWC'),
                                    feature_group_count=C)


def chunked_gated_delta_rule(q, k, v, g, beta):
    B, T, H, DK = q.shape
    DV = v.shape[-1]
    N = T // CHUNK

    def chunks(a):
        return jnp.moveaxis(a.reshape(B, N, CHUNK, H, *a.shape[3:]), 3, 1)

    q = chunks(q) * (DK ** -0.5)
    k = chunks(k)
    v = chunks(v)
    g = jnp.cumsum(chunks(g), axis=-1)
    beta = chunks(beta)
    causal = jnp.tril(jnp.ones((CHUNK, CHUNK), dtype=bool))
    strict = jnp.tril(jnp.ones((CHUNK, CHUNK), dtype=bool), -1)
    decay = jnp.exp(jnp.where(causal, g[..., :, None] - g[..., None, :], -jnp.inf))
    k_beta = k * beta[..., None]
    lower = jnp.where(strict, jnp.einsum('bhncd,bhnsd->bhncs', k_beta, k) * decay, 0.0)
    eye = jnp.eye(CHUNK, dtype=q.dtype)
    t_inv = lax.linalg.triangular_solve(eye + lower, jnp.broadcast_to(eye, lower.shape),
                                        left_side=True, lower=True)
    u = t_inv @ (v * beta[..., None])
    w = t_inv @ (k_beta * jnp.exp(g)[..., None])
    intra = jnp.where(causal, jnp.einsum('bhncd,bhnsd->bhncs', q, k) * decay, 0.0)

    def step(state, xs):
        q_c, k_c, u_c, w_c, g_c, a_c = xs
        v_new = u_c - w_c @ state
        o_c = (q_c * jnp.exp(g_c)[..., None]) @ state + a_c @ v_new
        g_last = g_c[..., -1:]
        state = state * jnp.exp(g_last)[..., None] + jnp.einsum(
            'bhcd,bhce->bhde', k_c * jnp.exp(g_last - g_c)[..., None], v_new)
        return state, o_c

    xs = tuple(jnp.moveaxis(a, 2, 0) for a in (q, k, u, w, g, intra))
    state0 = jnp.zeros((B, H, DK, DV), q.dtype)
    _, o = lax.scan(step, state0, xs)
    o = jnp.moveaxis(jnp.moveaxis(o, 0, 2), 1, 3)
    return o.reshape(B, T, H, DV)


def gated_deltanet_mixer(q_b, k_b, v_b, a_b, b_b, z_b, conv_w, a_log, dt_bias, o_norm):
    B, T, _ = q_b.shape
    qkv = jax.nn.silu(causal_depthwise_conv(jnp.concatenate([q_b, k_b, v_b], axis=-1), conv_w))
    q, k, v = jnp.split(qkv, 3, axis=-1)
    q = l2_norm(q.reshape(B, T, B_HEADS, B_HEAD_DIM))
    k = l2_norm(k.reshape(B, T, B_HEADS, B_HEAD_DIM))
    v = v.reshape(B, T, B_HEADS, B_HEAD_DIM).astype(jnp.float32)
    g = -jnp.exp(a_log.astype(jnp.float32)) * jax.nn.softplus(
        a_b.astype(jnp.float32) + dt_bias.astype(jnp.float32))
    beta = jax.nn.sigmoid(b_b.astype(jnp.float32))
    o = chunked_gated_delta_rule(q, k, v, g, beta)
    z = z_b.reshape(B, T, B_HEADS, B_HEAD_DIM).astype(jnp.float32)
    o = rms_norm(o, o_norm) * jax.nn.silu(z)
    return o.reshape(B, T, B_WIDTH).astype(q_b.dtype)


def hybrid_mixer(h, w_in, c_norm, w_uk, w_uv, rel_bias, conv_w, a_log, dt_bias, o_norm, w_out):
    proj = h @ w_in
    split_points = [int(p) for p in np.cumsum(np.array(_IN_SPLITS))[:-1]]
    q_a, c_kv, q_idx, k_idx, w_idx, q_b, k_b, v_b, a_b, b_b, z_b = jnp.split(proj, split_points, axis=-1)
    o_a = dsa_mixer(q_a, c_kv, q_idx, k_idx, w_idx, c_norm, w_uk, w_uv, rel_bias)
    o_b = gated_deltanet_mixer(q_b, k_b, v_b, a_b, b_b, z_b, conv_w, a_log, dt_bias, o_norm)
    return jnp.concatenate([o_a, o_b], axis=-1) @ w_out


def setup_inputs(seed: int = 0) -> dict:
    key = jax.random.key(seed)
    ks = jax.random.split(key, 18)
    f32 = jnp.float32

    def nrm(k, shape, scale):
        return jax.random.normal(k, shape, f32) * scale

    def gain(k, shape):
        return 1.0 + 0.01 * jax.random.normal(k, shape, f32)

    dt = jnp.exp(jax.random.uniform(ks[8], (DEPTH, B_HEADS), f32, math.log(1e-3), math.log(1e-1)))
    return {
        'x': nrm(ks[0], (BATCH, SEQ, D_MODEL), 1.0),
        'w_in': nrm(ks[1], (DEPTH, D_MODEL, IN_COLS), D_MODEL ** -0.5),
        'c_norm': gain(ks[2], (DEPTH, A_LATENT)),
        'w_uk': nrm(ks[3], (DEPTH, A_HEADS, A_LATENT, A_HEAD_DIM), A_LATENT ** -0.5),
        'w_uv': nrm(ks[4], (DEPTH, A_HEADS, A_LATENT, A_HEAD_DIM), A_LATENT ** -0.5),
        'rel_bias': nrm(ks[5], (REL_BUCKETS, A_HEADS), 0.5),
        'conv_w': nrm(ks[6], (DEPTH, CONV_WIDTH, 3 * B_WIDTH), CONV_WIDTH ** -0.5),
        'a_log': jnp.log(jax.random.uniform(ks[7], (DEPTH, B_HEADS), f32, 1.0, 16.0)),
        'dt_bias': dt + jnp.log(-jnp.expm1(-dt)),
        'o_norm': gain(ks[9], (DEPTH, B_HEAD_DIM)),
        'w_out': nrm(ks[10], (DEPTH, D_MIX, D_MODEL), D_MIX ** -0.5),
        'pre_norm_mix': gain(ks[11], (DEPTH, D_MODEL)),
        'post_norm_mix': gain(ks[12], (DEPTH, D_MODEL)),
        'pre_norm_mlp': gain(ks[13], (DEPTH, D_MODEL)),
        'post_norm_mlp': gain(ks[14], (DEPTH, D_MODEL)),
        'w_mlp_in': nrm(ks[15], (DEPTH, D_MODEL, D_FF), D_MODEL ** -0.5),
        'w_mlp_out': nrm(ks[16], (DEPTH, D_FF, D_MODEL), D_FF ** -0.5),
    }


def reference(x, w_in, c_norm, w_uk, w_uv, rel_bias, conv_w, a_log, dt_bias, o_norm, w_out,
              pre_norm_mix, post_norm_mix, pre_norm_mlp, post_norm_mlp, w_mlp_in, w_mlp_out):
    for l in range(DEPTH):
        h = rms_norm(x, pre_norm_mix[l])
        mix = hybrid_mixer(h, w_in[l], c_norm[l], w_uk[l], w_uv[l], rel_bias, conv_w[l],
                           a_log[l], dt_bias[l], o_norm[l], w_out[l])
        x = x + rms_norm(mix, post_norm_mix[l])
        h = rms_norm(x, pre_norm_mlp[l])
        y = jnp.square(jax.nn.relu(h @ w_mlp_in[l])) @ w_mlp_out[l]
        x = x + rms_norm(y, post_norm_mlp[l])
    return x
```

```cpp
#include <hip/hip_runtime.h>
#include <cstdio>
#include <cstdint>
namespace pg8 {
#define PG8_LAS __attribute__((address_space(3)))
typedef unsigned short bf16_t;
typedef short bf16x8 __attribute__((ext_vector_type(8)));
typedef float f32x4 __attribute__((ext_vector_type(4)));
typedef unsigned u32x4 __attribute__((ext_vector_type(4)));
constexpr int BM = 256, BK = 64, HALF = 128, HTB = HALF * BK * 2  , STAGE_BYTES = 8 * HTB, NXCD = 8, WGM = 8;

__host__ __device__ __forceinline__ int lds_byte(int r, int c) { const int st = (r >> 4) * 2 + (c >> 5), rr = r & 15, cc = c & 31, ob = rr * 64 + cc * 2; return st * 1024 + (ob ^ (((ob >> 9) & 1) << 5)); }
__host__ __device__ __forceinline__ void stage_rc(int b, int& R, int& C) { const int st = b / 1024, sb = b % 1024, swz = sb ^ (((sb >> 9) & 1) << 5); R = (st >> 1) * 16 + swz / 64; C = (st & 1) * 32 + (swz % 64) / 2; }
__host__ __device__ __forceinline__ int perm32(int rho) { const int n = rho >> 4, i = rho & 15; return 8 * (i >> 2) + 4 * n + (i & 3); }

struct Unit { int pm, pn; };
struct Gemm { const bf16_t* A; const bf16_t* Bt; int M, N, K; };

struct StaticOrder {
    int nM, nN, nwg, G, c;
    __host__ __device__ void init(int M, int N, int G_, int c_) { nM = M / BM; nN = N / BM; nwg = nM * nN; G = G_; c = c_; }
    __host__ __device__ bool next(int i, Unit& u) const {
        const long L = (long)i * G + c; if (L >= nwg) return false;
        int wgid = (int)L; { const int q = nwg / NXCD, r = nwg % NXCD, xcd = wgid % NXCD, off = wgid / NXCD; wgid = (xcd < r ? xcd * (q + 1) : r * (q + 1) + (xcd - r) * q) + off; }
        const int nig = WGM * nN, gid = wgid / nig, fm = gid * WGM, gsz = (nM - fm) < WGM ? (nM - fm) : WGM;
        u.pm = fm + ((wgid % nig) % gsz); u.pn = (wgid % nig) / gsz; return true;
    }
    __device__ __forceinline__ void a_ready(const Unit&) const {}
    __device__ __forceinline__ void done(const Unit&) const {}
};
__device__ __forceinline__ unsigned cvt_pk_bf16(float lo, float hi) { unsigned r; asm volatile("v_cvt_pk_bf16_f32 %0, %1, %2" : "=v"(r) : "v"(lo), "v"(hi)); return r; }
typedef float f32x2 __attribute__((ext_vector_type(2)));
struct EpiF32 {
    static constexpr bool PERM = false, AFTER_DRAIN = false;
    float* C; int ldc; const float* bias;
    __device__ __forceinline__ void operator()(const f32x4 (&acc)[2][2][4][2], const Unit& u, int wr, int wc, int fr, int fq) const {
        const int row0 = u.pm * BM + wr * 64 + fr, col0 = u.pn * BM + wc * 32 + 4 * fq;
        f32x4 bv[2][2];
#pragma unroll
        for (int bj = 0; bj < 2; ++bj)
#pragma unroll
            for (int n = 0; n < 2; ++n) bv[bj][n] = bias ? *(const f32x4*)(bias + col0 + bj * HALF + n * 16) : (f32x4){0.f, 0.f, 0.f, 0.f};
#pragma unroll
        for (int ai = 0; ai < 2; ++ai)
#pragma unroll
            for (int m = 0; m < 4; ++m) { float* rowp = C + (size_t)(row0 + ai * HALF + m * 16) * ldc + col0;
#pragma unroll
                for (int bj = 0; bj < 2; ++bj)
#pragma unroll
                    for (int n = 0; n < 2; ++n) *(f32x4*)(rowp + bj * HALF + n * 16) = acc[ai][bj][m][n] + bv[bj][n]; }
    }
};
struct EpiProj {
    static constexpr bool PERM = true, AFTER_DRAIN = false;
    bf16_t* O; int ldc; float* small;
    __device__ __forceinline__ void operator()(const f32x4 (&acc)[2][2][4][2], const Unit& u, int wr, int wc, int fr, int fq) const {
        const int row0 = u.pm * BM + wr * 64 + fr, col0 = u.pn * BM + wc * 32 + 8 * fq;
#pragma unroll
        for (int ai = 0; ai < 2; ++ai)
#pragma unroll
            for (int m = 0; m < 4; ++m) { bf16_t* rowp = O + (size_t)(row0 + ai * HALF + m * 16) * ldc + col0;
#pragma unroll
                for (int bj = 0; bj < 2; ++bj) { const f32x4 v0 = acc[ai][bj][m][0], v1 = acc[ai][bj][m][1];
                    u32x4 w; w.x = cvt_pk_bf16(v0[0], v0[1]); w.y = cvt_pk_bf16(v0[2], v0[3]); w.z = cvt_pk_bf16(v1[0], v1[1]); w.w = cvt_pk_bf16(v1[2], v1[3]);
                    *(u32x4*)(rowp + bj * HALF) = w; } }
        if (u.pn == 4 && wc == 2 && fq < 2) {
#pragma unroll
            for (int ai = 0; ai < 2; ++ai)
#pragma unroll
                for (int m = 0; m < 4; ++m) { float* sp = small + (size_t)(row0 + ai * HALF + m * 16) * 16 + 8 * fq;
                    *(f32x4*)sp = acc[ai][1][m][0]; *(f32x4*)(sp + 4) = acc[ai][1][m][1]; }
        }
    }
};
struct EpiRelu2 {
    static constexpr bool PERM = true, AFTER_DRAIN = false;
    bf16_t* O; int ldc;
    __device__ __forceinline__ void operator()(const f32x4 (&acc)[2][2][4][2], const Unit& u, int wr, int wc, int fr, int fq) const {
        const int row0 = u.pm * BM + wr * 64 + fr, col0 = u.pn * BM + wc * 32 + 8 * fq;
#pragma unroll
        for (int ai = 0; ai < 2; ++ai)
#pragma unroll
            for (int m = 0; m < 4; ++m) { bf16_t* rowp = O + (size_t)(row0 + ai * HALF + m * 16) * ldc + col0;
#pragma unroll
                for (int bj = 0; bj < 2; ++bj) { f32x4 v0 = acc[ai][bj][m][0], v1 = acc[ai][bj][m][1];
#pragma unroll
                    for (int j = 0; j < 4; ++j) { const float a = fmaxf(v0[j], 0.f), b = fmaxf(v1[j], 0.f); v0[j] = a * a; v1[j] = b * b; }
                    u32x4 w; w.x = cvt_pk_bf16(v0[0], v0[1]); w.y = cvt_pk_bf16(v0[2], v0[3]); w.z = cvt_pk_bf16(v1[0], v1[1]); w.w = cvt_pk_bf16(v1[2], v1[3]);
                    *(u32x4*)(rowp + bj * HALF) = w; } }
    }
};
template <class Epi, class Sched, bool STAMP = false>
__device__ __forceinline__ void gemm_phase(PG8_LAS unsigned char* lds, const Gemm g, const Sched& S, const Epi& E, unsigned long long* stamps) {
    const int tid = threadIdx.x, wid = __builtin_amdgcn_readfirstlane(tid >> 6), lane = tid & 63, wr = wid >> 2, wc = wid & 3, fr = lane & 15, fq = lane >> 4;
    const int K = g.K, nt = K / BK;
    int ts_lo = 0, ts_hi = 0, nts = 0; const unsigned long long rt_entry = STAMP ? (unsigned long long)wall_clock64() : 0ull;
#define PG8_STAMP() do { if (STAMP && wid == 0 && nts < 64) { const unsigned long long _c = (unsigned long long)clock64(); \
        ts_lo = (lane == nts) ? (int)(unsigned)_c : ts_lo; ts_hi = (lane == nts) ? (int)(unsigned)(_c >> 32) : ts_hi; ++nts; } } while (0)
    PG8_STAMP();
    unsigned voffA[2], voffB[2];
#pragma unroll
    for (int i = 0; i < 2; ++i) { int R, C; stage_rc(tid * 16 + i * 8192, R, C); const int Rb = Epi::PERM ? ((R & ~31) + perm32(R & 31)) : R;
        voffA[i] = (unsigned)(R * K + C) * 2u; voffB[i] = (unsigned)(Rb * K + C) * 2u; }
    const size_t kstep = (size_t)(BK * 2);
    const size_t hstep = (size_t)HALF * K * 2;
    const size_t tstep = 2 * hstep;
    const unsigned ldsw = (unsigned)wid * 1024u;
    const int aoff = lds_byte(wr * 64 + fr, fq * 8), boff = lds_byte(wc * 32 + fr, fq * 8);
#define PG8_SA(b, h) (((b) * 2 + (h)) * HTB)
#define PG8_SB(b, h) ((4 + (b) * 2 + (h)) * HTB)
#define PG8_STAGE(bufoff, gbase, voff) do { _Pragma("unroll") for (int _i = 0; _i < 2; ++_i) \
        __builtin_amdgcn_global_load_lds((const unsigned*)((const char*)(gbase) + (voff)[_i]), (PG8_LAS unsigned*)(lds + (bufoff) + ldsw + _i * 8192), 16, 0, 0); } while (0)
#define PG8_LDA(dst, b, h) do { _Pragma("unroll") for (int m = 0; m < 4; ++m) _Pragma("unroll") for (int k = 0; k < 2; ++k) dst[m][k] = *(const PG8_LAS bf16x8*)(lds + PG8_SA(b, h) + aoff + m * 2048 + k * 1024); } while (0)
#define PG8_LDB(dst, b, h) do { _Pragma("unroll") for (int n = 0; n < 2; ++n) _Pragma("unroll") for (int k = 0; k < 2; ++k) dst[n][k] = *(const PG8_LAS bf16x8*)(lds + PG8_SB(b, h) + boff + n * 2048 + k * 1024); } while (0)
#define PG8_MMA(ai, bj, At, Bt) do { __builtin_amdgcn_s_setprio(1); _Pragma("unroll") for (int m = 0; m < 4; ++m) _Pragma("unroll") for (int n = 0; n < 2; ++n) _Pragma("unroll") for (int k = 0; k < 2; ++k) \
        acc[ai][bj][m][n] = __builtin_amdgcn_mfma_f32_16x16x32_bf16(Bt[n][k], At[m][k], acc[ai][bj][m][n], 0, 0, 0); __builtin_amdgcn_s_setprio(0); } while (0)
#define PG8_WAIT_V(n) asm volatile("s_waitcnt vmcnt(" #n ")" ::: "memory")
#define PG8_WAIT_L(n) asm volatile("s_waitcnt lgkmcnt(" #n ")" ::: "memory")
#define PG8_BAR __builtin_amdgcn_s_barrier()
#define PG8_SCHED __builtin_amdgcn_sched_barrier(0)
    Unit cur, nxt; int ui = 0;
    if (!S.next(0, cur)) return;
    f32x4 acc[2][2][4][2];
#pragma unroll
    for (int a = 0; a < 2; ++a)
#pragma unroll
        for (int b = 0; b < 2; ++b)
#pragma unroll
            for (int m = 0; m < 4; ++m)
#pragma unroll
                for (int n = 0; n < 2; ++n) acc[a][b][m][n] = (f32x4){0.f, 0.f, 0.f, 0.f};
    bf16x8 At[4][2], B0[2][2], B1[2][2];
    const char* cA = (const char*)g.A + (size_t)cur.pm * tstep; const char* cB = (const char*)g.Bt + (size_t)cur.pn * tstep;
    S.a_ready(cur);
    PG8_STAGE(PG8_SB(0, 0), cB, voffB); PG8_STAGE(PG8_SA(0, 0), cA, voffA); PG8_STAGE(PG8_SB(0, 1), cB + hstep, voffB); PG8_STAGE(PG8_SA(0, 1), cA + hstep, voffA);
    if (wr == 1) PG8_BAR;
    PG8_WAIT_V(4); PG8_BAR;
    PG8_STAGE(PG8_SB(1, 0), cB + kstep, voffB); PG8_STAGE(PG8_SA(1, 0), cA + kstep, voffA); PG8_STAGE(PG8_SB(1, 1), cB + hstep + kstep, voffB);
    PG8_WAIT_V(6); PG8_BAR;
    PG8_STAMP();
    for (;;) {
        const bool has_next = S.next(ui + 1, nxt);
        const char* nA = has_next ? (const char*)g.A + (size_t)nxt.pm * tstep : cA; const char* nB = has_next ? (const char*)g.Bt + (size_t)nxt.pn * tstep : cB;
        for (int t = 0; t < nt; t += 2) {
            const bool last = (t == nt - 2);
            const char* a1 = cA + (size_t)(t + 1) * kstep;
            const char* a2 = last ? nA : cA + (size_t)(t + 2) * kstep; const char* b2 = last ? nB : cB + (size_t)(t + 2) * kstep;
            const char* a3 = a2 + kstep; const char* b3 = b2 + kstep;
            if (last && has_next) S.a_ready(nxt);
            PG8_LDB(B0, 0, 0); PG8_SCHED; PG8_LDA(At, 0, 0); PG8_STAGE(PG8_SA(1, 1), a1 + hstep, voffA);
            PG8_WAIT_L(8); PG8_BAR; PG8_WAIT_L(0); PG8_MMA(0, 0, At, B0); PG8_BAR; PG8_SCHED;
            PG8_LDB(B1, 0, 1); PG8_STAGE(PG8_SB(0, 0), b2, voffB);
            PG8_BAR; PG8_WAIT_L(0); PG8_MMA(0, 1, At, B1); PG8_BAR;
            PG8_LDA(At, 0, 1); PG8_STAGE(PG8_SA(0, 0), a2, voffA);
            PG8_BAR; PG8_WAIT_L(0); PG8_MMA(1, 0, At, B0); PG8_BAR; PG8_SCHED;
            PG8_STAGE(PG8_SB(0, 1), b2 + hstep, voffB);
            PG8_WAIT_V(6); PG8_BAR; PG8_MMA(1, 1, At, B1); PG8_BAR;
            PG8_LDB(B0, 1, 0); PG8_SCHED; PG8_LDA(At, 1, 0); PG8_STAGE(PG8_SA(0, 1), a2 + hstep, voffA);
            PG8_WAIT_L(8); PG8_BAR; PG8_WAIT_L(0); PG8_MMA(0, 0, At, B0); PG8_BAR; PG8_SCHED;
            PG8_LDB(B1, 1, 1); PG8_STAGE(PG8_SB(1, 0), b3, voffB);
            PG8_BAR; PG8_WAIT_L(0); PG8_MMA(0, 1, At, B1); PG8_BAR;
            PG8_LDA(At, 1, 1); PG8_STAGE(PG8_SA(1, 0), a3, voffA);
            PG8_BAR; PG8_WAIT_L(0); PG8_MMA(1, 0, At, B0); PG8_BAR; PG8_SCHED;
            PG8_STAGE(PG8_SB(1, 1), b3 + hstep, voffB);
            PG8_WAIT_V(6); PG8_BAR; PG8_MMA(1, 1, At, B1); PG8_BAR;
        }
        PG8_STAMP();
        if constexpr (!Epi::AFTER_DRAIN) { E(acc, cur, wr, wc, fr, fq); S.done(cur); }
        PG8_STAMP();
        if (!has_next) break;
#pragma unroll
        for (int a = 0; a < 2; ++a)
#pragma unroll
            for (int b = 0; b < 2; ++b)
#pragma unroll
                for (int m = 0; m < 4; ++m)
#pragma unroll
                    for (int n = 0; n < 2; ++n) acc[a][b][m][n] = (f32x4){0.f, 0.f, 0.f, 0.f};
        cur = nxt; cA = nA; cB = nB; ++ui;
    }
    PG8_WAIT_V(0);
    if (wr == 0) PG8_BAR;
    PG8_BAR;
    if constexpr (Epi::AFTER_DRAIN) { E.fused(acc, cur, wr, wc, fr, fq, lds, wid, lane); S.done(cur); }
    PG8_STAMP();
    if (STAMP && wid == 0) { stamps[lane] = lane < nts ? (((unsigned long long)(unsigned)ts_hi << 32) | (unsigned)ts_lo) : 0ull;
        if (lane == 62) stamps[62] = rt_entry; if (lane == 63) stamps[63] = (unsigned long long)wall_clock64(); }
#undef PG8_STAMP
#undef PG8_SA
#undef PG8_SB
#undef PG8_STAGE
#undef PG8_LDA
#undef PG8_LDB
#undef PG8_MMA
#undef PG8_WAIT_V
#undef PG8_WAIT_L
#undef PG8_BAR
#undef PG8_SCHED
}
}
#define XB_TMO      128
#define XB_XCNT(j)  (256  + 64 * (j))
#define XB_XSUB(j)  (1280 + 64 * (j))
#define XB_XGEN(j)  (2304 + 64 * (j))
#define XB_TOP      3328
#define XB_TOPGEN   3392
#define XCD_BAR_WORDS 3456
#define XB_SPIN_CAP (1u << 18)
#define LAS __attribute__((address_space(3)))

__device__ __forceinline__ unsigned xb_ld(unsigned* p)              { return __hip_atomic_load(p, __ATOMIC_RELAXED, __HIP_MEMORY_SCOPE_AGENT); }
__device__ __forceinline__ unsigned xb_add(unsigned* p, unsigned v) { return __hip_atomic_fetch_add(p, v, __ATOMIC_RELAXED, __HIP_MEMORY_SCOPE_AGENT); }
__device__ __forceinline__ unsigned xb_xcc_id() { return (unsigned)__builtin_amdgcn_s_getreg((3 << 11) | 20) & 0xFu; }
#define XB_SPIN(cond, bar) do { unsigned _sp = 0; while (cond) { __builtin_amdgcn_s_sleep(1); \
    if ((++_sp & 255u) == 0u) { if (xb_ld(&(bar)[XB_TMO])) break; if (_sp > XB_SPIN_CAP) { atomicAdd(&(bar)[XB_TMO], 1u); break; } } } } while (0)

struct XcdBarrier {
    unsigned* bar; unsigned x;
    volatile LAS unsigned* st;
};

__device__ __forceinline__ XcdBarrier xcd_barrier_post(unsigned* bar, volatile LAS unsigned* st) {
    XcdBarrier b; b.bar = bar; b.x = xb_xcc_id(); b.st = st;
    if (threadIdx.x == 0) (void)xb_add(&bar[XB_XCNT(b.x)], 1u);
    return b;
}
__device__ __forceinline__ void xcd_barrier_complete(unsigned* bar, unsigned x, unsigned& nloc, unsigned& nx) {
    const unsigned G = gridDim.x * gridDim.y * gridDim.z;
    unsigned sum, cnt, mine, sp = 0u;
    for (;;) {
        sum = 0u; cnt = 0u; mine = 0u;
#pragma unroll
        for (unsigned j = 0; j < 16; ++j) { const unsigned c = xb_ld(&bar[XB_XCNT(j)]); sum += c; cnt += (c > 0u) ? 1u : 0u; mine = (j == x) ? c : mine; }
        if (sum == G) break;
        __builtin_amdgcn_s_sleep(1);
        if ((++sp & 255u) == 0u) { if (xb_ld(&bar[XB_TMO])) break; if (sp > XB_SPIN_CAP) { atomicAdd(&bar[XB_TMO], 1u); break; } }
    }
    nloc = mine > 0u ? mine : 1u; nx = cnt > 0u ? cnt : 1u;
}

__device__ __forceinline__ void xcd_barrier(const XcdBarrier& b) {
    asm volatile("s_waitcnt vmcnt(0)" ::: "memory");
    __syncthreads();
    if (threadIdx.x == 0) {
        unsigned* bar = b.bar;
        __builtin_amdgcn_s_waitcnt(0);
        unsigned nloc = b.st[0], nx = b.st[1];
        if (nloc == 0u) { xcd_barrier_complete(bar, b.x, nloc, nx); b.st[0] = nloc; b.st[1] = nx; }
        const unsigned old = xb_add(&bar[XB_XSUB(b.x)], 1u);
        const unsigned gen = old / nloc;
        if (old + 1u == (gen + 1u) * nloc) {
            __builtin_amdgcn_fence(__ATOMIC_RELEASE, "agent");
            asm volatile("s_waitcnt vmcnt(0)" ::: "memory");
            const unsigned og = xb_add(&bar[XB_TOP], 1u);
            const unsigned tg = og / nx;
            if (og + 1u == (tg + 1u) * nx) xb_add(&bar[XB_TOPGEN], 1u);
            else XB_SPIN(xb_ld(&bar[XB_TOPGEN]) == tg, bar);
            __builtin_amdgcn_fence(__ATOMIC_ACQUIRE, "agent");
            xb_add(&bar[XB_XGEN(b.x)], 1u);
            asm volatile("s_waitcnt vmcnt(0)" ::: "memory");
        } else {
            XB_SPIN(xb_ld(&bar[XB_XGEN(b.x)]) == gen, bar);
            __builtin_amdgcn_fence(__ATOMIC_ACQUIRE, "agent");
            asm volatile("s_waitcnt vmcnt(0)" ::: "memory");
        }
    }
    __syncthreads();
}
#ifndef MK_N_LAUNCHES
#define MK_N_LAUNCHES 9
#endif
constexpr int NPHASE = 9;
constexpr int BATCH = 16, SEQ = 2048, DM = 1024, MROWS = BATCH * SEQ, NPROJ = 3840, DFF = 4096, KOUT = 1536, INC = 3280;
constexpr float EPS = 1e-6f;
constexpr int PC_QABS = 0, PC_CKV = 1024, PC_KIDX = 1152, PC_SMALL = 1216, PC_QIDX = 1280, PC_QB = 1792, PC_KB = 2304, PC_VB = 2816, PC_ZB = 3328;
constexpr size_t MiB = 1u << 20;
constexpr size_t WS_CTL = 0, CTL_ZERO_BYTES = 1 * MiB;
constexpr size_t WS_WMI = 1 * MiB, WS_WMO = 9 * MiB, WS_R1 = 17 * MiB, WS_WOUT = 113 * MiB, WS_WIN = 116 * MiB, WS_SMALL = 124 * MiB, WS_CN = 126 * MiB, WS_PROJ = 134 * MiB;
constexpr size_t WS_MIX = 134 * MiB, WS_ACT = 116 * MiB, WS_Y = 372 * MiB, WS_END = 500 * MiB;
constexpr int CW_BAR = 4096;
constexpr int LDS_BYTES = 147456, MISC_OFF = LDS_BYTES - 64;

typedef unsigned short bf16;
typedef unsigned v4u __attribute__((ext_vector_type(4)));
typedef float f32x4 __attribute__((ext_vector_type(4)));
typedef float f32x2 __attribute__((ext_vector_type(2)));
#define LDS_WAIT() asm volatile("s_waitcnt lgkmcnt(0)" ::: "memory")
__device__ __forceinline__ unsigned f2bf(float f) { unsigned u = __float_as_uint(f); return (u + 0x7fffu + ((u >> 16) & 1u)) >> 16; }
__device__ __forceinline__ unsigned pk2(float lo, float hi) { return f2bf(lo) | (f2bf(hi) << 16); }
__device__ __forceinline__ float bflo(unsigned u) { return __uint_as_float(u << 16); }
__device__ __forceinline__ float bfhi(unsigned u) { return __uint_as_float(u & 0xffff0000u); }
__device__ __forceinline__ float bf2f(bf16 b) { return __uint_as_float(((unsigned)b) << 16); }
__device__ __forceinline__ float wave_sum(float v) {
#pragma unroll
    for (int o = 1; o < 64; o <<= 1) v += __shfl_xor(v, o);
    return v;
}
__device__ __forceinline__ float wave_max(float v) {
#pragma unroll
    for (int o = 1; o < 64; o <<= 1) v = fmaxf(v, __shfl_xor(v, o));
    return v;
}
__device__ __forceinline__ float silu_f(float x) { return x / (1.0f + __expf(-x)); }
__device__ __forceinline__ float sigmoid_f(float x) { return 1.0f / (1.0f + __expf(-x)); }
__device__ __forceinline__ float softplus_f(float x) { return fmaxf(x, 0.f) + log1pf(__expf(-fabsf(x))); }
__device__ __forceinline__ int t5_bucket(int rel) {
    const int side = rel > 0 ? 16 : 0, n = rel < 0 ? -rel : rel;
    int bk;
    if (n < 8) bk = n; else bk = 8 + (n >= 12) + (n >= 16) + (n >= 23) + (n >= 32) + (n >= 46) + (n >= 64) + (n >= 91);
    return side + bk;
}

struct Args { const float* in[17]; float* out; unsigned char* ws; int ph_lo, ph_hi; };
struct Ctx {
    int tid, lane, wave, G, gw, NGW;
    LAS unsigned char* lds;
    const float *x, *w_in, *c_norm, *w_uk, *w_uv, *rel_bias, *conv_w, *a_log, *dt_bias, *o_norm, *w_out, *g_pre_mix, *g_post_mix, *g_pre_mlp, *g_post_mlp, *w_mi, *w_mo;
    float* out;
    bf16 *WinT, *WoutT, *WmiT, *WmoT, *R1, *proj, *cn, *act;
    float *small, *mix, *y;
};

__device__ __forceinline__ void tr_item(const float* W, int ldsrc, int sc0, bf16* WT, int ldd, int dr0, int dc0, float scale, LAS float* scr, int kb, int nb, int lane) {
    const int k0 = 64 * kb, n0 = 32 * nb;
#pragma unroll 8
    for (int i = 0; i < 32; ++i) { const int kk = 2 * i + (lane >> 5); scr[kk * 33 + (lane & 31)] = W[(size_t)(k0 + kk) * ldsrc + sc0 + n0 + (lane & 31)]; }
    LDS_WAIT();
    const int c = lane & 7;
#pragma unroll
    for (int j = 0; j < 4; ++j) { const int n = (lane >> 3) + 8 * j; const LAS float* s = scr + (8 * c) * 33 + n;
        v4u o; o.x = pk2(s[0 * 33] * scale, s[1 * 33] * scale); o.y = pk2(s[2 * 33] * scale, s[3 * 33] * scale); o.z = pk2(s[4 * 33] * scale, s[5 * 33] * scale); o.w = pk2(s[6 * 33] * scale, s[7 * 33] * scale);
        *(v4u*)(WT + (size_t)(dr0 + n0 + n) * ldd + dc0 + k0 + 8 * c) = o; }
    LDS_WAIT();
}
__device__ __forceinline__ void rms_row_to_bf16(const float* xrow, const float* g, bf16* orow, int lane) {
    const f32x4* xr = (const f32x4*)xrow + lane; const f32x4* gr = (const f32x4*)g + lane;
    f32x4 v[4]; float s = 0.f;
#pragma unroll
    for (int j = 0; j < 4; ++j) { v[j] = xr[64 * j]; s += (v[j].x * v[j].x + v[j].y * v[j].y) + (v[j].z * v[j].z + v[j].w * v[j].w); }
    const float rstd = 1.0f / sqrtf(wave_sum(s) * (1.0f / DM) + EPS);
    unsigned long long* o8 = (unsigned long long*)orow + lane;
#pragma unroll
    for (int j = 0; j < 4; ++j) { const f32x4 gg = gr[64 * j];
        o8[64 * j] = (unsigned long long)pk2(v[j].x * rstd * gg.x, v[j].y * rstd * gg.y) | ((unsigned long long)pk2(v[j].z * rstd * gg.z, v[j].w * rstd * gg.w) << 32); }
}
__device__ __forceinline__ void p0_prologue(const Ctx& C) {
    LAS float* scr = (LAS float*)(C.lds + C.wave * 8704);
    const int lane = C.lane;
    for (int it = C.gw; it < 6496; it += C.NGW) {
        int r = it;
        if (r < 64)   { tr_item(C.w_in, INC, 512, C.WinT, DM, PC_CKV, 0, 1.f, scr, r / 4, r % 4, lane); continue; } r -= 64;
        if (r < 32)   { tr_item(C.w_in, INC, 1152, C.WinT, DM, PC_KIDX, 0, 1.f, scr, r / 2, r % 2, lane); continue; } r -= 32;
        if (r < 256)  { tr_item(C.w_in, INC, 640, C.WinT, DM, PC_QIDX, 0, 0.125f, scr, r / 16, r % 16, lane); continue; } r -= 256;
        if (r < 768)  { tr_item(C.w_in, INC, 1224, C.WinT, DM, PC_QB, 0, 1.f, scr, r / 48, r % 48, lane); continue; } r -= 768;
        if (r < 256)  { tr_item(C.w_in, INC, 2768, C.WinT, DM, PC_ZB, 0, 1.f, scr, r / 16, r % 16, lane); continue; } r -= 256;
        if (r < 256)  { tr_item(C.w_out + 512 * 1024, DM, 0, C.WoutT, KOUT, 0, 1024, 1.f, scr, r / 32, r % 32, lane); continue; } r -= 256;
        if (r < 2048) { tr_item(C.w_mi, DFF, 0, C.WmiT, DM, 0, 0, 1.f, scr, r / 128, r % 128, lane); continue; } r -= 2048;
        if (r < 2048) { tr_item(C.w_mo, DM, 0, C.WmoT, DFF, 0, 0, 1.f, scr, r / 32, r % 32, lane); continue; } r -= 2048;
        if (r < 512) {
            const int hh = r / 64, rem = r % 64, kblk = rem / 4, cq = rem % 4, k = kblk * 64 + lane;
            float wr[64]; const f32x4* src = (const f32x4*)(C.w_in + (size_t)k * INC + hh * 64);
#pragma unroll
            for (int i = 0; i < 16; ++i) { const f32x4 v = src[i]; wr[4 * i] = v.x; wr[4 * i + 1] = v.y; wr[4 * i + 2] = v.z; wr[4 * i + 3] = v.w; }
#pragma unroll 1
            for (int c = cq * 32; c < cq * 32 + 32; ++c) { const float* uk = C.w_uk + (size_t)(hh * 128 + c) * 64; float acc = 0.f;
#pragma unroll
                for (int d4 = 0; d4 < 4; ++d4) {
#pragma unroll
                    for (int d = 0; d < 16; ++d) acc += wr[d4 * 16 + d] * uk[d4 * 16 + d];
                    asm volatile("" ::: "memory"); }
                C.WinT[(size_t)(hh * 128 + c) * DM + k] = (bf16)f2bf(acc * 0.125f); }
            continue; } r -= 512;
        {
            const int hh = r / 32, rem = r % 32, cblk = rem / 16, nq = rem % 16, c = cblk * 64 + lane;
            float ur[64]; const f32x4* src = (const f32x4*)(C.w_uv + (size_t)(hh * 128 + c) * 64);
#pragma unroll
            for (int i = 0; i < 16; ++i) { const f32x4 v = src[i]; ur[4 * i] = v.x; ur[4 * i + 1] = v.y; ur[4 * i + 2] = v.z; ur[4 * i + 3] = v.w; }
#pragma unroll 1
            for (int n = nq * 64; n < nq * 64 + 64; ++n) { const float* wo = C.w_out + (size_t)(hh * 64) * DM + n; float acc = 0.f;
#pragma unroll
                for (int d4 = 0; d4 < 4; ++d4) {
#pragma unroll
                    for (int d = 0; d < 16; ++d) acc += ur[d4 * 16 + d] * wo[(size_t)(d4 * 16 + d) * DM];
                    asm volatile("" ::: "memory"); }
                C.WoutT[(size_t)n * KOUT + hh * 128 + c] = (bf16)f2bf(acc); }
        }
    }
    for (int i = blockIdx.x * 512 + C.tid; i < 64 * DM; i += C.G * 512) { const int r = i >> 10, k = i & 1023; float v = 0.f;
        if (r < 8) v = C.w_in[(size_t)k * INC + 1216 + r]; else if (r < 12) v = C.w_in[(size_t)k * INC + 2760 + (r - 8)]; else if (r < 16) v = C.w_in[(size_t)k * INC + 2764 + (r - 12)];
        C.WinT[(size_t)(PC_SMALL + r) * DM + k] = (bf16)f2bf(v); }
    for (int m = C.gw; m < MROWS; m += C.NGW) rms_row_to_bf16(C.x + (size_t)m * DM, C.g_pre_mix, C.R1 + (size_t)m * DM, lane);
}

__device__ __forceinline__ void p2_cn(const Ctx& C) {
    const int lane = C.lane; const float g0 = C.c_norm[2 * lane], g1 = C.c_norm[2 * lane + 1];
    for (int m = C.gw; m < MROWS; m += C.NGW) {
        const unsigned u = *(const unsigned*)(C.proj + (size_t)m * NPROJ + PC_CKV + 2 * lane); const float a = bflo(u), b = bfhi(u);
        const float r = 1.0f / sqrtf(wave_sum(a * a + b * b) * (1.0f / 128.f) + EPS);
        *(unsigned*)(C.cn + (size_t)m * 128 + 2 * lane) = pk2(a * r * g0, b * r * g1); }
}
__device__ __forceinline__ void p2_gdn_seq(const Ctx& C, int b, int h) {
    LAS float* qs = (LAS float*)C.lds; LAS float* ks = qs + 8192; LAS float* vs = ks + 8192; LAS float* ob = vs + 8192; LAS float* gl = ob + 8192; LAS float* bl = gl + 64;
    const int lane = C.lane, wave = C.wave, tid = C.tid;
    float S[128];
#pragma unroll
    for (int i = 0; i < 128; ++i) S[i] = 0.f;
    const float A = __expf(C.a_log[h]), dtb = C.dt_bias[h];
    const float on0 = C.o_norm[2 * lane], on1 = C.o_norm[2 * lane + 1];
    for (int chunk = 0; chunk < 32; ++chunk) {
        const int t0 = chunk * 64;
#pragma unroll 1
        for (int rr = 0; rr < 8; ++rr) { const int r = wave * 8 + rr, t = t0 + r;
#pragma unroll 1
            for (int X = 0; X < 3; ++X) { const int ch = X * 512 + h * 128 + 2 * lane; float a0 = 0.f, a1 = 0.f;
#pragma unroll
                for (int j = 0; j < 4; ++j) { const int tt = t - 3 + j;
                    if (tt >= 0) { const unsigned u = *(const unsigned*)(C.proj + (size_t)(b * SEQ + tt) * NPROJ + PC_QB + ch);
                        a0 += C.conv_w[j * 1536 + ch] * bflo(u); a1 += C.conv_w[j * 1536 + ch + 1] * bfhi(u); } }
                float y0 = silu_f(a0), y1 = silu_f(a1);
                if (X < 2) { const float rn = 1.0f / sqrtf(wave_sum(y0 * y0 + y1 * y1) + EPS); y0 *= rn; y1 *= rn; }
                if (X == 0) { y0 *= 0.08838834764831845f; y1 *= 0.08838834764831845f; }
                LAS float* dst = (X == 0 ? qs : X == 1 ? ks : vs) + r * 128 + 2 * lane; dst[0] = y0; dst[1] = y1; } }
        if (tid < 64) { const size_t m = (size_t)b * SEQ + t0 + tid; const float av = C.small[m * 16 + 8 + h], bv = C.small[m * 16 + 12 + h];
            gl[tid] = -A * softplus_f(av + dtb); bl[tid] = sigmoid_f(bv); }
        __syncthreads();
        if (tid < 128) {
#pragma unroll 1
            for (int t = 0; t < 64; ++t) { const float a = __expf(gl[t]), bt = bl[t]; const LAS float* kr = ks + t * 128; const LAS float* qr = qs + t * 128;
                float kS = 0.f;
#pragma unroll
                for (int d4 = 0; d4 < 8; ++d4) {
#pragma unroll
                    for (int d = 0; d < 16; ++d) kS += kr[d4 * 16 + d] * S[d4 * 16 + d];
                    asm volatile("" ::: "memory"); }
                const float dl = bt * (vs[t * 128 + tid] - a * kS); float o = 0.f;
#pragma unroll
                for (int d4 = 0; d4 < 8; ++d4) {
#pragma unroll
                    for (int d = 0; d < 16; ++d) { const int dd = d4 * 16 + d; S[dd] = a * S[dd] + kr[dd] * dl; o += qr[dd] * S[dd]; }
                    asm volatile("" ::: "memory"); }
                ob[t * 128 + tid] = o; } }
        __syncthreads();
#pragma unroll 1
        for (int rr = 0; rr < 8; ++rr) { const int r = wave * 8 + rr; const size_t m = (size_t)b * SEQ + t0 + r;
            const float o0 = ob[r * 128 + 2 * lane], o1 = ob[r * 128 + 2 * lane + 1];
            const float rstd = 1.0f / sqrtf(wave_sum(o0 * o0 + o1 * o1) * (1.0f / 128.f) + EPS);
            const unsigned zu = *(const unsigned*)(C.proj + m * NPROJ + PC_ZB + h * 128 + 2 * lane);
            *(unsigned*)(C.R1 + m * KOUT + 1024 + h * 128 + 2 * lane) = pk2(o0 * rstd * on0 * silu_f(bflo(zu)), o1 * rstd * on1 * silu_f(bfhi(zu))); }
        __syncthreads();
    }
}

__device__ __forceinline__ unsigned f2key(float f) { unsigned u = __float_as_uint(f); if (u == 0x80000000u) u = 0u; return (u & 0x80000000u) ? ~u : (u | 0x80000000u); }
__device__ __forceinline__ void p3_dsa_query(const Ctx& C, int b, int t, LAS unsigned char* wl) {
    const int lane = C.lane; const size_t m = (size_t)b * SEQ + t; const int N = ((t >> 6) + 1) << 6, ntile = N >> 6, nsel = N < 256 ? N : 256;
    LAS float* qi = (LAS float*)wl; LAS float* qa = qi + 512; LAS int* idx = (LAS int*)(qa + 1024); LAS unsigned* sc = (LAS unsigned*)(idx + 256); LAS float* pp = (LAS float*)sc;
    const bf16* prow = C.proj + m * NPROJ;
#pragma unroll
    for (int i = 0; i < 8; ++i) qi[i * 64 + lane] = bf2f(prow[PC_QIDX + i * 64 + lane]);
#pragma unroll
    for (int i = 0; i < 16; ++i) qa[i * 64 + lane] = bf2f(prow[PC_QABS + i * 64 + lane]);
    float wi[8];
#pragma unroll
    for (int hh = 0; hh < 8; ++hh) wi[hh] = C.small[m * 16 + hh] * 0.35355339059327373f;
    LDS_WAIT();
#pragma unroll 1
    for (int i = 0; i < ntile; ++i) { const int s = i * 64 + lane; const v4u* kr = (const v4u*)(C.proj + (size_t)(b * SEQ + s) * NPROJ + PC_KIDX);
        float kf[64];
#pragma unroll
        for (int j = 0; j < 8; ++j) { const v4u u = kr[j]; kf[8 * j] = bflo(u.x); kf[8 * j + 1] = bfhi(u.x); kf[8 * j + 2] = bflo(u.y); kf[8 * j + 3] = bfhi(u.y); kf[8 * j + 4] = bflo(u.z); kf[8 * j + 5] = bfhi(u.z); kf[8 * j + 6] = bflo(u.w); kf[8 * j + 7] = bfhi(u.w); }
        float score = 0.f;
#pragma unroll
        for (int hh = 0; hh < 8; ++hh) { float d = 0.f;
#pragma unroll
            for (int e = 0; e < 64; ++e) d += qi[hh * 64 + e] * kf[e];
            score += wi[hh] * fmaxf(d, 0.f); asm volatile("" ::: "memory"); }
        sc[s] = f2key(score); }
    LDS_WAIT();
    if (N <= 256) {
        for (int i = 0; i < ntile; ++i) idx[i * 64 + lane] = i * 64 + lane;
    } else {
        unsigned uk[32];
#pragma unroll
        for (int i = 0; i < 32; ++i) uk[i] = (i < ntile) ? sc[i * 64 + lane] : 0u;
        unsigned K = 0u;
#pragma unroll 1
        for (int bit = 31; bit >= 0; --bit) { const unsigned cand = K | (1u << bit); int cnt = 0;
#pragma unroll
            for (int i = 0; i < 32; ++i) if (i < ntile) cnt += __popcll(__ballot(uk[i] >= cand));
            if (cnt >= 256) K = cand; }
        int cgt = 0;
#pragma unroll
        for (int i = 0; i < 32; ++i) if (i < ntile) cgt += __popcll(__ballot(uk[i] > K));
        const int need = 256 - cgt; int base = 0, tie_seen = 0; const unsigned long long lt = (1ull << lane) - 1ull;
#pragma unroll
        for (int i = 0; i < 32; ++i) if (i < ntile) {
            const bool gt = uk[i] > K, eq = uk[i] == K; const unsigned long long mEq = __ballot(eq);
            const int rank_eq = tie_seen + __popcll(mEq & lt); const bool sel = gt || (eq && rank_eq < need);
            const unsigned long long mSel = __ballot(sel); const int pos = base + __popcll(mSel & lt);
            if (sel) idx[pos] = i * 64 + lane;
            base += __popcll(mSel); tie_seen += __popcll(mEq); }
    }
    LDS_WAIT();
#pragma unroll 1
    for (int jj = 0; jj < 4; ++jj) { const int j = jj * 64 + lane;
        if (j < nsel) { const int s = idx[j]; const v4u* cr = (const v4u*)(C.cn + (size_t)(b * SEQ + s) * 128);
            float acc[8];
#pragma unroll
            for (int hh = 0; hh < 8; ++hh) acc[hh] = 0.f;
#pragma unroll 1
            for (int cc = 0; cc < 16; ++cc) { const v4u u = cr[cc]; float cv[8]; cv[0] = bflo(u.x); cv[1] = bfhi(u.x); cv[2] = bflo(u.y); cv[3] = bfhi(u.y); cv[4] = bflo(u.z); cv[5] = bfhi(u.z); cv[6] = bflo(u.w); cv[7] = bfhi(u.w);
#pragma unroll
                for (int hh = 0; hh < 8; ++hh)
#pragma unroll
                    for (int e = 0; e < 8; ++e) acc[hh] += qa[hh * 128 + cc * 8 + e] * cv[e]; }
            const int bk = t5_bucket(s - t);
#pragma unroll
            for (int hh = 0; hh < 8; ++hh) pp[j * 8 + hh] = acc[hh] + C.rel_bias[bk * 8 + hh];
        } else {
#pragma unroll
            for (int hh = 0; hh < 8; ++hh) pp[j * 8 + hh] = -__builtin_inff();
        } }
    LDS_WAIT();
#pragma unroll
    for (int hh = 0; hh < 8; ++hh) { float v[4]; float mx = -__builtin_inff();
#pragma unroll
        for (int jj = 0; jj < 4; ++jj) { v[jj] = pp[(jj * 64 + lane) * 8 + hh]; mx = fmaxf(mx, v[jj]); }
        mx = wave_max(mx); float sm = 0.f;
#pragma unroll
        for (int jj = 0; jj < 4; ++jj) { v[jj] = __expf(v[jj] - mx); sm += v[jj]; }
        sm = 1.0f / wave_sum(sm);
#pragma unroll
        for (int jj = 0; jj < 4; ++jj) pp[(jj * 64 + lane) * 8 + hh] = v[jj] * sm; }
    LDS_WAIT();
    float o0[8], o1[8];
#pragma unroll
    for (int hh = 0; hh < 8; ++hh) { o0[hh] = 0.f; o1[hh] = 0.f; }
#pragma unroll 2
    for (int j = 0; j < nsel; ++j) { const int s = idx[j]; const unsigned u = *(const unsigned*)(C.cn + (size_t)(b * SEQ + s) * 128 + 2 * lane); const float c0 = bflo(u), c1 = bfhi(u);
        const f32x4 pa = *(const LAS f32x4*)(pp + j * 8), pb = *(const LAS f32x4*)(pp + j * 8 + 4);
        o0[0] += pa.x * c0; o1[0] += pa.x * c1; o0[1] += pa.y * c0; o1[1] += pa.y * c1; o0[2] += pa.z * c0; o1[2] += pa.z * c1; o0[3] += pa.w * c0; o1[3] += pa.w * c1;
        o0[4] += pb.x * c0; o1[4] += pb.x * c1; o0[5] += pb.y * c0; o1[5] += pb.y * c1; o0[6] += pb.z * c0; o1[6] += pb.z * c1; o0[7] += pb.w * c0; o1[7] += pb.w * c1; }
#pragma unroll
    for (int hh = 0; hh < 8; ++hh) *(unsigned*)(C.R1 + m * KOUT + hh * 128 + 2 * lane) = pk2(o0[hh], o1[hh]);
    LDS_WAIT();
}
__device__ __forceinline__ void p3_dsa(const Ctx& C) {
    LAS unsigned char* wl = C.lds + C.wave * 15360;
    for (int q = C.gw; q < MROWS; q += C.NGW) { const int b = q >> 11, t = ((q & 2047) + 128 * b) & 2047; p3_dsa_query(C, b, t, wl); }
}

__device__ __forceinline__ void p5_postnorm(const Ctx& C) {
    const int lane = C.lane;
    for (int m = C.gw; m < MROWS; m += C.NGW) {
        const f32x4* mr = (const f32x4*)(C.mix + (size_t)m * DM) + lane; const f32x4* xr = (const f32x4*)(C.x + (size_t)m * DM) + lane; f32x4* orow = (f32x4*)(C.out + (size_t)m * DM) + lane;
        const f32x4* g1 = (const f32x4*)C.g_post_mix + lane; const f32x4* g2 = (const f32x4*)C.g_pre_mlp + lane;
        f32x4 v[4]; float s = 0.f;
#pragma unroll
        for (int j = 0; j < 4; ++j) { v[j] = mr[64 * j]; s += (v[j].x * v[j].x + v[j].y * v[j].y) + (v[j].z * v[j].z + v[j].w * v[j].w); }
        const float rstd = 1.0f / sqrtf(wave_sum(s) * (1.0f / DM) + EPS); float s2 = 0.f;
#pragma unroll
        for (int j = 0; j < 4; ++j) { v[j] = xr[64 * j] + v[j] * rstd * g1[64 * j]; orow[64 * j] = v[j]; s2 += (v[j].x * v[j].x + v[j].y * v[j].y) + (v[j].z * v[j].z + v[j].w * v[j].w); }
        const float rstd2 = 1.0f / sqrtf(wave_sum(s2) * (1.0f / DM) + EPS);
        unsigned long long* o8 = (unsigned long long*)(C.R1 + (size_t)m * DM) + lane;
#pragma unroll
        for (int j = 0; j < 4; ++j) { const f32x4 gg = g2[64 * j];
            o8[64 * j] = (unsigned long long)pk2(v[j].x * rstd2 * gg.x, v[j].y * rstd2 * gg.y) | ((unsigned long long)pk2(v[j].z * rstd2 * gg.z, v[j].w * rstd2 * gg.w) << 32); }
    }
}
__device__ __forceinline__ void p8_final(const Ctx& C) {
    const int lane = C.lane;
    for (int m = C.gw; m < MROWS; m += C.NGW) {
        const f32x4* yr = (const f32x4*)(C.y + (size_t)m * DM) + lane; f32x4* orow = (f32x4*)(C.out + (size_t)m * DM) + lane; const f32x4* g1 = (const f32x4*)C.g_post_mlp + lane;
        f32x4 v[4]; float s = 0.f;
#pragma unroll
        for (int j = 0; j < 4; ++j) { v[j] = yr[64 * j]; s += (v[j].x * v[j].x + v[j].y * v[j].y) + (v[j].z * v[j].z + v[j].w * v[j].w); }
        const float rstd = 1.0f / sqrtf(wave_sum(s) * (1.0f / DM) + EPS);
#pragma unroll
        for (int j = 0; j < 4; ++j) orow[64 * j] = orow[64 * j] + v[j] * rstd * g1[64 * j];
    }
}

__global__ void __launch_bounds__(512, 2) fwd(Args a) {
    extern __shared__ __attribute__((aligned(16))) unsigned char lds_raw[];
    Ctx C;
    C.lds = (LAS unsigned char*)lds_raw;
    C.tid = threadIdx.x; C.lane = C.tid & 63; C.wave = __builtin_amdgcn_readfirstlane(C.tid >> 6); C.G = gridDim.x; C.gw = blockIdx.x * 8 + C.wave; C.NGW = C.G * 8;
    C.x = a.in[0]; C.w_in = a.in[1]; C.c_norm = a.in[2]; C.w_uk = a.in[3]; C.w_uv = a.in[4]; C.rel_bias = a.in[5]; C.conv_w = a.in[6]; C.a_log = a.in[7]; C.dt_bias = a.in[8]; C.o_norm = a.in[9];
    C.w_out = a.in[10]; C.g_pre_mix = a.in[11]; C.g_post_mix = a.in[12]; C.g_pre_mlp = a.in[13]; C.g_post_mlp = a.in[14]; C.w_mi = a.in[15]; C.w_mo = a.in[16]; C.out = a.out;
    unsigned char* ws = a.ws;
    C.WinT = (bf16*)(ws + WS_WIN); C.WoutT = (bf16*)(ws + WS_WOUT); C.WmiT = (bf16*)(ws + WS_WMI); C.WmoT = (bf16*)(ws + WS_WMO); C.R1 = (bf16*)(ws + WS_R1); C.proj = (bf16*)(ws + WS_PROJ);
    C.cn = (bf16*)(ws + WS_CN); C.act = (bf16*)(ws + WS_ACT); C.small = (float*)(ws + WS_SMALL); C.mix = (float*)(ws + WS_MIX); C.y = (float*)(ws + WS_Y);
    volatile LAS unsigned* MISC = (volatile LAS unsigned*)(C.lds + MISC_OFF);
    if (C.tid < 16) MISC[C.tid] = 0u;
    __syncthreads();
    const int lo = a.ph_lo, hi = a.ph_hi;
    XcdBarrier bar; bar.bar = (unsigned*)(ws + WS_CTL) + CW_BAR; bar.x = 0; bar.st = nullptr;
    if (hi - lo > 1) bar = xcd_barrier_post((unsigned*)(ws + WS_CTL) + CW_BAR, MISC);
#define IN(k) (lo <= (k) && (k) < hi)
#define SEAM(k) do { if (IN(k) && IN((k) + 1)) xcd_barrier(bar); } while (0)

#ifndef NO_P0
    if (IN(0)) { p0_prologue(C); SEAM(0); }
#endif
#ifndef NO_GEMM
    if (IN(1)) { pg8::Gemm g{C.R1, C.WinT, MROWS, NPROJ, DM}; pg8::StaticOrder S; S.init(MROWS, NPROJ, C.G, (int)blockIdx.x);
        pg8::EpiProj E{C.proj, NPROJ, C.small};
        pg8::gemm_phase<pg8::EpiProj, pg8::StaticOrder, false>(C.lds, g, S, E, nullptr); SEAM(1); }
#endif
#ifndef NO_P2
    if (IN(2)) { p2_cn(C); if (blockIdx.x < 64) p2_gdn_seq(C, blockIdx.x >> 2, blockIdx.x & 3); SEAM(2); }
#endif
#ifndef NO_P3
    if (IN(3)) { p3_dsa(C); SEAM(3); }
#endif
#ifndef NO_GEMM
    if (IN(4)) { pg8::Gemm g{C.R1, C.WoutT, MROWS, DM, KOUT}; pg8::StaticOrder S; S.init(MROWS, DM, C.G, (int)blockIdx.x);
        pg8::EpiF32 E{C.mix, DM, nullptr};
        pg8::gemm_phase<pg8::EpiF32, pg8::StaticOrder, false>(C.lds, g, S, E, nullptr); SEAM(4); }
#endif
    if (IN(5)) { p5_postnorm(C); SEAM(5); }
#ifndef NO_GEMM
    if (IN(6)) { pg8::Gemm g{C.R1, C.WmiT, MROWS, DFF, DM}; pg8::StaticOrder S; S.init(MROWS, DFF, C.G, (int)blockIdx.x);
        pg8::EpiRelu2 E{C.act, DFF};
        pg8::gemm_phase<pg8::EpiRelu2, pg8::StaticOrder, false>(C.lds, g, S, E, nullptr); SEAM(6); }
    if (IN(7)) { pg8::Gemm g{C.act, C.WmoT, MROWS, DM, DFF}; pg8::StaticOrder S; S.init(MROWS, DM, C.G, (int)blockIdx.x);
        pg8::EpiF32 E{C.y, DM, nullptr};
        pg8::gemm_phase<pg8::EpiF32, pg8::StaticOrder, false>(C.lds, g, S, E, nullptr); SEAM(7); }
#endif
    if (IN(8)) { p8_final(C); }
#undef IN
#undef SEAM
}

extern "C" void kernel_launch(void* const* d_in, const int* in_sizes, int n_in, void* d_out, int out_size, void* d_ws, size_t ws_size, hipStream_t stream) {
    static int grid = 0;
    if (grid == 0) {
        if (n_in != 17 || in_sizes[0] != MROWS * DM || out_size != MROWS * DM || ws_size < WS_END) {
            fprintf(stderr, "kernel_launch: built for 17 inputs, x/out of %d floats, >= %zu bytes of workspace; got n_in %d, in0 %d, out %d, ws %zu; nothing launched\n", MROWS * DM, (size_t)WS_END, n_in, n_in > 0 ? in_sizes[0] : -1, out_size, ws_size); grid = -1; return; }
        int dev = 0, cus = 0, per_cu = 0;
        if (hipGetDevice(&dev) != hipSuccess || hipDeviceGetAttribute(&cus, hipDeviceAttributeMultiprocessorCount, dev) != hipSuccess) { fprintf(stderr, "kernel_launch: device query failed\n"); grid = -1; return; }
        if (hipFuncSetAttribute((const void*)fwd, hipFuncAttributeMaxDynamicSharedMemorySize, LDS_BYTES) != hipSuccess) { fprintf(stderr, "kernel_launch: hipFuncSetAttribute failed\n"); grid = -1; return; }
        if (hipOccupancyMaxActiveBlocksPerMultiprocessor(&per_cu, (const void*)fwd, 512, LDS_BYTES) != hipSuccess || per_cu < 1)
            fprintf(stderr, "kernel_launch: note: occupancy query reports %d workgroups per CU\n", per_cu);
        (void)hipGetLastError();
        grid = cus;
        if (grid < 64) { fprintf(stderr, "kernel_launch: needs >= 64 CUs\n"); grid = -1; return; }
    }
    if (grid < 0) return;
    if (hipMemsetAsync((char*)d_ws + WS_CTL, 0, CTL_ZERO_BYTES, stream) != hipSuccess) { fprintf(stderr, "kernel_launch: memset failed\n"); return; }
    Args a{};
    for (int i = 0; i < 17; ++i) a.in[i] = (const float*)d_in[i];
    a.out = (float*)d_out; a.ws = (unsigned char*)d_ws;
    if (MK_N_LAUNCHES == 1) { a.ph_lo = 0; a.ph_hi = NPHASE; hipLaunchKernelGGL(fwd, dim3(grid), dim3(512), LDS_BYTES, stream, a); }
    else for (int p = 0; p < NPHASE; ++p) { a.ph_lo = p; a.ph_hi = p + 1; hipLaunchKernelGGL(fwd, dim3(grid), dim3(512), LDS_BYTES, stream, a); }
    const hipError_t le = hipPeekAtLastError();
    if (le != hipSuccess) fprintf(stderr, "kernel_launch: launch failed: %s\n", hipGetErrorName(le));
}
```

```cpp
#include <hip/hip_runtime.h>
#include <cstdio>
#include <cstdint>
namespace pg8 {
#define PG8_LAS __attribute__((address_space(3)))
typedef unsigned short bf16_t;
typedef short bf16x8 __attribute__((ext_vector_type(8)));
typedef float f32x4 __attribute__((ext_vector_type(4)));
typedef unsigned u32x4 __attribute__((ext_vector_type(4)));
constexpr int BM = 256, BK = 64, HALF = 128, HTB = HALF * BK * 2  , STAGE_BYTES = 8 * HTB, NXCD = 8, WGM = 8;

__host__ __device__ __forceinline__ int lds_byte(int r, int c) { const int st = (r >> 4) * 2 + (c >> 5), rr = r & 15, cc = c & 31, ob = rr * 64 + cc * 2; return st * 1024 + (ob ^ (((ob >> 9) & 1) << 5)); }
__host__ __device__ __forceinline__ void stage_rc(int b, int& R, int& C) { const int st = b / 1024, sb = b % 1024, swz = sb ^ (((sb >> 9) & 1) << 5); R = (st >> 1) * 16 + swz / 64; C = (st & 1) * 32 + (swz % 64) / 2; }
__host__ __device__ __forceinline__ int perm32(int rho) { const int n = rho >> 4, i = rho & 15; return 8 * (i >> 2) + 4 * n + (i & 3); }

struct Unit { int pm, pn; };
struct Gemm { const bf16_t* A; const bf16_t* Bt; int M, N, K; };

struct StaticOrder {
    int nM, nN, nwg, G, c;
    __host__ __device__ void init(int M, int N, int G_, int c_) { nM = M / BM; nN = N / BM; nwg = nM * nN; G = G_; c = c_; }
    __host__ __device__ bool next(int i, Unit& u) const {
        const long L = (long)i * G + c; if (L >= nwg) return false;
        int wgid = (int)L; { const int q = nwg / NXCD, r = nwg % NXCD, xcd = wgid % NXCD, off = wgid / NXCD; wgid = (xcd < r ? xcd * (q + 1) : r * (q + 1) + (xcd - r) * q) + off; }
        const int nig = WGM * nN, gid = wgid / nig, fm = gid * WGM, gsz = (nM - fm) < WGM ? (nM - fm) : WGM;
        u.pm = fm + ((wgid % nig) % gsz); u.pn = (wgid % nig) / gsz; return true;
    }
    __device__ __forceinline__ void a_ready(const Unit&) const {}
    __device__ __forceinline__ void done(const Unit&) const {}
};
__device__ __forceinline__ unsigned cvt_pk_bf16(float lo, float hi) { unsigned r; asm volatile("v_cvt_pk_bf16_f32 %0, %1, %2" : "=v"(r) : "v"(lo), "v"(hi)); return r; }
typedef float f32x2 __attribute__((ext_vector_type(2)));
struct EpiF32 {
    static constexpr bool PERM = false, AFTER_DRAIN = false;
    float* C; int ldc; const float* bias;
    __device__ __forceinline__ void operator()(const f32x4 (&acc)[2][2][4][2], const Unit& u, int wr, int wc, int fr, int fq) const {
        const int row0 = u.pm * BM + wr * 64 + fr, col0 = u.pn * BM + wc * 32 + 4 * fq;
        f32x4 bv[2][2];
#pragma unroll
        for (int bj = 0; bj < 2; ++bj)
#pragma unroll
            for (int n = 0; n < 2; ++n) bv[bj][n] = bias ? *(const f32x4*)(bias + col0 + bj * HALF + n * 16) : (f32x4){0.f, 0.f, 0.f, 0.f};
#pragma unroll
        for (int ai = 0; ai < 2; ++ai)
#pragma unroll
            for (int m = 0; m < 4; ++m) { float* rowp = C + (size_t)(row0 + ai * HALF + m * 16) * ldc + col0;
#pragma unroll
                for (int bj = 0; bj < 2; ++bj)
#pragma unroll
                    for (int n = 0; n < 2; ++n) *(f32x4*)(rowp + bj * HALF + n * 16) = acc[ai][bj][m][n] + bv[bj][n]; }
    }
};
struct EpiProj {
    static constexpr bool PERM = true, AFTER_DRAIN = false;
    bf16_t* O; int ldc; float* small;
    __device__ __forceinline__ void operator()(const f32x4 (&acc)[2][2][4][2], const Unit& u, int wr, int wc, int fr, int fq) const {
        const int row0 = u.pm * BM + wr * 64 + fr, col0 = u.pn * BM + wc * 32 + 8 * fq;
#pragma unroll
        for (int ai = 0; ai < 2; ++ai)
#pragma unroll
            for (int m = 0; m < 4; ++m) { bf16_t* rowp = O + (size_t)(row0 + ai * HALF + m * 16) * ldc + col0;
#pragma unroll
                for (int bj = 0; bj < 2; ++bj) { const f32x4 v0 = acc[ai][bj][m][0], v1 = acc[ai][bj][m][1];
                    u32x4 w; w.x = cvt_pk_bf16(v0[0], v0[1]); w.y = cvt_pk_bf16(v0[2], v0[3]); w.z = cvt_pk_bf16(v1[0], v1[1]); w.w = cvt_pk_bf16(v1[2], v1[3]);
                    *(u32x4*)(rowp + bj * HALF) = w; } }
        if (u.pn == 4 && wc == 2 && fq < 2) {
#pragma unroll
            for (int ai = 0; ai < 2; ++ai)
#pragma unroll
                for (int m = 0; m < 4; ++m) { float* sp = small + (size_t)(row0 + ai * HALF + m * 16) * 16 + 8 * fq;
                    *(f32x4*)sp = acc[ai][1][m][0]; *(f32x4*)(sp + 4) = acc[ai][1][m][1]; }
        }
    }
};
struct EpiRelu2 {
    static constexpr bool PERM = true, AFTER_DRAIN = false;
    bf16_t* O; int ldc;
    __device__ __forceinline__ void operator()(const f32x4 (&acc)[2][2][4][2], const Unit& u, int wr, int wc, int fr, int fq) const {
        const int row0 = u.pm * BM + wr * 64 + fr, col0 = u.pn * BM + wc * 32 + 8 * fq;
#pragma unroll
        for (int ai = 0; ai < 2; ++ai)
#pragma unroll
            for (int m = 0; m < 4; ++m) { bf16_t* rowp = O + (size_t)(row0 + ai * HALF + m * 16) * ldc + col0;
#pragma unroll
                for (int bj = 0; bj < 2; ++bj) { f32x4 v0 = acc[ai][bj][m][0], v1 = acc[ai][bj][m][1];
#pragma unroll
                    for (int j = 0; j < 4; ++j) { const float a = fmaxf(v0[j], 0.f), b = fmaxf(v1[j], 0.f); v0[j] = a * a; v1[j] = b * b; }
                    u32x4 w; w.x = cvt_pk_bf16(v0[0], v0[1]); w.y = cvt_pk_bf16(v0[2], v0[3]); w.z = cvt_pk_bf16(v1[0], v1[1]); w.w = cvt_pk_bf16(v1[2], v1[3]);
                    *(u32x4*)(rowp + bj * HALF) = w; } }
    }
};
template <class Epi, class Sched, bool STAMP = false>
__device__ __forceinline__ void gemm_phase(PG8_LAS unsigned char* lds, const Gemm g, const Sched& S, const Epi& E, unsigned long long* stamps) {
    const int tid = threadIdx.x, wid = __builtin_amdgcn_readfirstlane(tid >> 6), lane = tid & 63, wr = wid >> 2, wc = wid & 3, fr = lane & 15, fq = lane >> 4;
    const int K = g.K, nt = K / BK;
    int ts_lo = 0, ts_hi = 0, nts = 0; const unsigned long long rt_entry = STAMP ? (unsigned long long)wall_clock64() : 0ull;
#define PG8_STAMP() do { if (STAMP && wid == 0 && nts < 64) { const unsigned long long _c = (unsigned long long)clock64(); \
        ts_lo = (lane == nts) ? (int)(unsigned)_c : ts_lo; ts_hi = (lane == nts) ? (int)(unsigned)(_c >> 32) : ts_hi; ++nts; } } while (0)
    PG8_STAMP();
    unsigned voffA[2], voffB[2];
#pragma unroll
    for (int i = 0; i < 2; ++i) { int R, C; stage_rc(tid * 16 + i * 8192, R, C); const int Rb = Epi::PERM ? ((R & ~31) + perm32(R & 31)) : R;
        voffA[i] = (unsigned)(R * K + C) * 2u; voffB[i] = (unsigned)(Rb * K + C) * 2u; }
    const size_t kstep = (size_t)(BK * 2);
    const size_t hstep = (size_t)HALF * K * 2;
    const size_t tstep = 2 * hstep;
    const unsigned ldsw = (unsigned)wid * 1024u;
    const int aoff = lds_byte(wr * 64 + fr, fq * 8), boff = lds_byte(wc * 32 + fr, fq * 8);
#define PG8_SA(b, h) (((b) * 2 + (h)) * HTB)
#define PG8_SB(b, h) ((4 + (b) * 2 + (h)) * HTB)
#define PG8_STAGE(bufoff, gbase, voff) do { _Pragma("unroll") for (int _i = 0; _i < 2; ++_i) \
        __builtin_amdgcn_global_load_lds((const unsigned*)((const char*)(gbase) + (voff)[_i]), (PG8_LAS unsigned*)(lds + (bufoff) + ldsw + _i * 8192), 16, 0, 0); } while (0)
#define PG8_LDA(dst, b, h) do { _Pragma("unroll") for (int m = 0; m < 4; ++m) _Pragma("unroll") for (int k = 0; k < 2; ++k) dst[m][k] = *(const PG8_LAS bf16x8*)(lds + PG8_SA(b, h) + aoff + m * 2048 + k * 1024); } while (0)
#define PG8_LDB(dst, b, h) do { _Pragma("unroll") for (int n = 0; n < 2; ++n) _Pragma("unroll") for (int k = 0; k < 2; ++k) dst[n][k] = *(const PG8_LAS bf16x8*)(lds + PG8_SB(b, h) + boff + n * 2048 + k * 1024); } while (0)
#define PG8_MMA(ai, bj, At, Bt) do { __builtin_amdgcn_s_setprio(1); _Pragma("unroll") for (int m = 0; m < 4; ++m) _Pragma("unroll") for (int n = 0; n < 2; ++n) _Pragma("unroll") for (int k = 0; k < 2; ++k) \
        acc[ai][bj][m][n] = __builtin_amdgcn_mfma_f32_16x16x32_bf16(Bt[n][k], At[m][k], acc[ai][bj][m][n], 0, 0, 0); __builtin_amdgcn_s_setprio(0); } while (0)
#define PG8_WAIT_V(n) asm volatile("s_waitcnt vmcnt(" #n ")" ::: "memory")
#define PG8_WAIT_L(n) asm volatile("s_waitcnt lgkmcnt(" #n ")" ::: "memory")
#define PG8_BAR __builtin_amdgcn_s_barrier()
#define PG8_SCHED __builtin_amdgcn_sched_barrier(0)
    Unit cur, nxt; int ui = 0;
    if (!S.next(0, cur)) return;
    f32x4 acc[2][2][4][2];
#pragma unroll
    for (int a = 0; a < 2; ++a)
#pragma unroll
        for (int b = 0; b < 2; ++b)
#pragma unroll
            for (int m = 0; m < 4; ++m)
#pragma unroll
                for (int n = 0; n < 2; ++n) acc[a][b][m][n] = (f32x4){0.f, 0.f, 0.f, 0.f};
    bf16x8 At[4][2], B0[2][2], B1[2][2];
    const char* cA = (const char*)g.A + (size_t)cur.pm * tstep; const char* cB = (const char*)g.Bt + (size_t)cur.pn * tstep;
    S.a_ready(cur);
    PG8_STAGE(PG8_SB(0, 0), cB, voffB); PG8_STAGE(PG8_SA(0, 0), cA, voffA); PG8_STAGE(PG8_SB(0, 1), cB + hstep, voffB); PG8_STAGE(PG8_SA(0, 1), cA + hstep, voffA);
    if (wr == 1) PG8_BAR;
    PG8_WAIT_V(4); PG8_BAR;
    PG8_STAGE(PG8_SB(1, 0), cB + kstep, voffB); PG8_STAGE(PG8_SA(1, 0), cA + kstep, voffA); PG8_STAGE(PG8_SB(1, 1), cB + hstep + kstep, voffB);
    PG8_WAIT_V(6); PG8_BAR;
    PG8_STAMP();
    for (;;) {
        const bool has_next = S.next(ui + 1, nxt);
        const char* nA = has_next ? (const char*)g.A + (size_t)nxt.pm * tstep : cA; const char* nB = has_next ? (const char*)g.Bt + (size_t)nxt.pn * tstep : cB;
        for (int t = 0; t < nt; t += 2) {
            const bool last = (t == nt - 2);
            const char* a1 = cA + (size_t)(t + 1) * kstep;
            const char* a2 = last ? nA : cA + (size_t)(t + 2) * kstep; const char* b2 = last ? nB : cB + (size_t)(t + 2) * kstep;
            const char* a3 = a2 + kstep; const char* b3 = b2 + kstep;
            if (last && has_next) S.a_ready(nxt);
            PG8_LDB(B0, 0, 0); PG8_SCHED; PG8_LDA(At, 0, 0); PG8_STAGE(PG8_SA(1, 1), a1 + hstep, voffA);
            PG8_WAIT_L(8); PG8_BAR; PG8_WAIT_L(0); PG8_MMA(0, 0, At, B0); PG8_BAR; PG8_SCHED;
            PG8_LDB(B1, 0, 1); PG8_STAGE(PG8_SB(0, 0), b2, voffB);
            PG8_BAR; PG8_WAIT_L(0); PG8_MMA(0, 1, At, B1); PG8_BAR;
            PG8_LDA(At, 0, 1); PG8_STAGE(PG8_SA(0, 0), a2, voffA);
            PG8_BAR; PG8_WAIT_L(0); PG8_MMA(1, 0, At, B0); PG8_BAR; PG8_SCHED;
            PG8_STAGE(PG8_SB(0, 1), b2 + hstep, voffB);
            PG8_WAIT_V(6); PG8_BAR; PG8_MMA(1, 1, At, B1); PG8_BAR;
            PG8_LDB(B0, 1, 0); PG8_SCHED; PG8_LDA(At, 1, 0); PG8_STAGE(PG8_SA(0, 1), a2 + hstep, voffA);
            PG8_WAIT_L(8); PG8_BAR; PG8_WAIT_L(0); PG8_MMA(0, 0, At, B0); PG8_BAR; PG8_SCHED;
            PG8_LDB(B1, 1, 1); PG8_STAGE(PG8_SB(1, 0), b3, voffB);
            PG8_BAR; PG8_WAIT_L(0); PG8_MMA(0, 1, At, B1); PG8_BAR;
            PG8_LDA(At, 1, 1); PG8_STAGE(PG8_SA(1, 0), a3, voffA);
            PG8_BAR; PG8_WAIT_L(0); PG8_MMA(1, 0, At, B0); PG8_BAR; PG8_SCHED;
            PG8_STAGE(PG8_SB(1, 1), b3 + hstep, voffB);
            PG8_WAIT_V(6); PG8_BAR; PG8_MMA(1, 1, At, B1); PG8_BAR;
        }
        PG8_STAMP();
        if constexpr (!Epi::AFTER_DRAIN) { E(acc, cur, wr, wc, fr, fq); S.done(cur); }
        PG8_STAMP();
        if (!has_next) break;
#pragma unroll
        for (int a = 0; a < 2; ++a)
#pragma unroll
            for (int b = 0; b < 2; ++b)
#pragma unroll
                for (int m = 0; m < 4; ++m)
#pragma unroll
                    for (int n = 0; n < 2; ++n) acc[a][b][m][n] = (f32x4){0.f, 0.f, 0.f, 0.f};
        cur = nxt; cA = nA; cB = nB; ++ui;
    }
    PG8_WAIT_V(0);
    if (wr == 0) PG8_BAR;
    PG8_BAR;
    if constexpr (Epi::AFTER_DRAIN) { E.fused(acc, cur, wr, wc, fr, fq, lds, wid, lane); S.done(cur); }
    PG8_STAMP();
    if (STAMP && wid == 0) { stamps[lane] = lane < nts ? (((unsigned long long)(unsigned)ts_hi << 32) | (unsigned)ts_lo) : 0ull;
        if (lane == 62) stamps[62] = rt_entry; if (lane == 63) stamps[63] = (unsigned long long)wall_clock64(); }
#undef PG8_STAMP
#undef PG8_SA
#undef PG8_SB
#undef PG8_STAGE
#undef PG8_LDA
#undef PG8_LDB
#undef PG8_MMA
#undef PG8_WAIT_V
#undef PG8_WAIT_L
#undef PG8_BAR
#undef PG8_SCHED
}
}
#define XB_TMO      128
#define XB_XCNT(j)  (256  + 64 * (j))
#define XB_XSUB(j)  (1280 + 64 * (j))
#define XB_XGEN(j)  (2304 + 64 * (j))
#define XB_TOP      3328
#define XB_TOPGEN   3392
#define XCD_BAR_WORDS 3456
#define XB_SPIN_CAP (1u << 18)
#define LAS __attribute__((address_space(3)))

__device__ __forceinline__ unsigned xb_ld(unsigned* p)              { return __hip_atomic_load(p, __ATOMIC_RELAXED, __HIP_MEMORY_SCOPE_AGENT); }
__device__ __forceinline__ unsigned xb_add(unsigned* p, unsigned v) { return __hip_atomic_fetch_add(p, v, __ATOMIC_RELAXED, __HIP_MEMORY_SCOPE_AGENT); }
__device__ __forceinline__ unsigned xb_xcc_id() { return (unsigned)__builtin_amdgcn_s_getreg((3 << 11) | 20) & 0xFu; }
#define XB_SPIN(cond, bar) do { unsigned _sp = 0; while (cond) { __builtin_amdgcn_s_sleep(1); \
    if ((++_sp & 255u) == 0u) { if (xb_ld(&(bar)[XB_TMO])) break; if (_sp > XB_SPIN_CAP) { atomicAdd(&(bar)[XB_TMO], 1u); break; } } } } while (0)

struct XcdBarrier {
    unsigned* bar; unsigned x;
    volatile LAS unsigned* st;
};

__device__ __forceinline__ XcdBarrier xcd_barrier_post(unsigned* bar, volatile LAS unsigned* st) {
    XcdBarrier b; b.bar = bar; b.x = xb_xcc_id(); b.st = st;
    if (threadIdx.x == 0) (void)xb_add(&bar[XB_XCNT(b.x)], 1u);
    return b;
}
__device__ __forceinline__ void xcd_barrier_complete(unsigned* bar, unsigned x, unsigned& nloc, unsigned& nx) {
    const unsigned G = gridDim.x * gridDim.y * gridDim.z;
    unsigned sum, cnt, mine, sp = 0u;
    for (;;) {
        sum = 0u; cnt = 0u; mine = 0u;
#pragma unroll
        for (unsigned j = 0; j < 16; ++j) { const unsigned c = xb_ld(&bar[XB_XCNT(j)]); sum += c; cnt += (c > 0u) ? 1u : 0u; mine = (j == x) ? c : mine; }
        if (sum == G) break;
        __builtin_amdgcn_s_sleep(1);
        if ((++sp & 255u) == 0u) { if (xb_ld(&bar[XB_TMO])) break; if (sp > XB_SPIN_CAP) { atomicAdd(&bar[XB_TMO], 1u); break; } }
    }
    nloc = mine > 0u ? mine : 1u; nx = cnt > 0u ? cnt : 1u;
}

__device__ __forceinline__ void xcd_barrier(const XcdBarrier& b) {
    asm volatile("s_waitcnt vmcnt(0)" ::: "memory");
    __syncthreads();
    if (threadIdx.x == 0) {
        unsigned* bar = b.bar;
        __builtin_amdgcn_s_waitcnt(0);
        unsigned nloc = b.st[0], nx = b.st[1];
        if (nloc == 0u) { xcd_barrier_complete(bar, b.x, nloc, nx); b.st[0] = nloc; b.st[1] = nx; }
        const unsigned old = xb_add(&bar[XB_XSUB(b.x)], 1u);
        const unsigned gen = old / nloc;
        if (old + 1u == (gen + 1u) * nloc) {
            __builtin_amdgcn_fence(__ATOMIC_RELEASE, "agent");
            asm volatile("s_waitcnt vmcnt(0)" ::: "memory");
            const unsigned og = xb_add(&bar[XB_TOP], 1u);
            const unsigned tg = og / nx;
            if (og + 1u == (tg + 1u) * nx) xb_add(&bar[XB_TOPGEN], 1u);
            else XB_SPIN(xb_ld(&bar[XB_TOPGEN]) == tg, bar);
            __builtin_amdgcn_fence(__ATOMIC_ACQUIRE, "agent");
            xb_add(&bar[XB_XGEN(b.x)], 1u);
            asm volatile("s_waitcnt vmcnt(0)" ::: "memory");
        } else {
            XB_SPIN(xb_ld(&bar[XB_XGEN(b.x)]) == gen, bar);
            __builtin_amdgcn_fence(__ATOMIC_ACQUIRE, "agent");
            asm volatile("s_waitcnt vmcnt(0)" ::: "memory");
        }
    }
    __syncthreads();
}
#ifndef MK_N_LAUNCHES
#define MK_N_LAUNCHES 1
#endif
constexpr int NPHASE = 9;
constexpr int BATCH = 16, SEQ = 2048, DM = 1024, MROWS = BATCH * SEQ, NPROJ = 3840, DFF = 4096, KOUT = 1536, INC = 3280;
constexpr float EPS = 1e-6f;
constexpr int PC_QABS = 0, PC_CKV = 1024, PC_KIDX = 1152, PC_SMALL = 1216, PC_QIDX = 1280, PC_QB = 1792, PC_KB = 2304, PC_VB = 2816, PC_ZB = 3328;
constexpr size_t MiB = 1u << 20;
constexpr size_t WS_CTL = 0, CTL_ZERO_BYTES = 1 * MiB;
constexpr size_t WS_WMI = 1 * MiB, WS_WMO = 9 * MiB, WS_R1 = 17 * MiB, WS_WOUT = 113 * MiB, WS_WIN = 116 * MiB, WS_SMALL = 124 * MiB, WS_CN = 126 * MiB, WS_PROJ = 134 * MiB;
constexpr size_t WS_MIX = 134 * MiB, WS_ACT = 116 * MiB, WS_Y = 372 * MiB, WS_END = 500 * MiB;
constexpr int CW_BAR = 4096;
constexpr int LDS_BYTES = 147456, MISC_OFF = LDS_BYTES - 64;

typedef unsigned short bf16;
typedef unsigned v4u __attribute__((ext_vector_type(4)));
typedef float f32x4 __attribute__((ext_vector_type(4)));
typedef float f32x2 __attribute__((ext_vector_type(2)));
#define LDS_WAIT() asm volatile("s_waitcnt lgkmcnt(0)" ::: "memory")
__device__ __forceinline__ unsigned f2bf(float f) { unsigned u = __float_as_uint(f); return (u + 0x7fffu + ((u >> 16) & 1u)) >> 16; }
__device__ __forceinline__ unsigned pk2(float lo, float hi) { return f2bf(lo) | (f2bf(hi) << 16); }
__device__ __forceinline__ float bflo(unsigned u) { return __uint_as_float(u << 16); }
__device__ __forceinline__ float bfhi(unsigned u) { return __uint_as_float(u & 0xffff0000u); }
__device__ __forceinline__ float bf2f(bf16 b) { return __uint_as_float(((unsigned)b) << 16); }
__device__ __forceinline__ float wave_sum(float v) {
#pragma unroll
    for (int o = 1; o < 64; o <<= 1) v += __shfl_xor(v, o);
    return v;
}
__device__ __forceinline__ float wave_max(float v) {
#pragma unroll
    for (int o = 1; o < 64; o <<= 1) v = fmaxf(v, __shfl_xor(v, o));
    return v;
}
__device__ __forceinline__ float silu_f(float x) { return x / (1.0f + __expf(-x)); }
__device__ __forceinline__ float sigmoid_f(float x) { return 1.0f / (1.0f + __expf(-x)); }
__device__ __forceinline__ float softplus_f(float x) { return fmaxf(x, 0.f) + log1pf(__expf(-fabsf(x))); }
__device__ __forceinline__ int t5_bucket(int rel) {
    const int side = rel > 0 ? 16 : 0, n = rel < 0 ? -rel : rel;
    int bk;
    if (n < 8) bk = n; else bk = 8 + (n >= 12) + (n >= 16) + (n >= 23) + (n >= 32) + (n >= 46) + (n >= 64) + (n >= 91);
    return side + bk;
}

struct Args { const float* in[17]; float* out; unsigned char* ws; int ph_lo, ph_hi; };
struct Ctx {
    int tid, lane, wave, G, gw, NGW;
    LAS unsigned char* lds;
    const float *x, *w_in, *c_norm, *w_uk, *w_uv, *rel_bias, *conv_w, *a_log, *dt_bias, *o_norm, *w_out, *g_pre_mix, *g_post_mix, *g_pre_mlp, *g_post_mlp, *w_mi, *w_mo;
    float* out;
    bf16 *WinT, *WoutT, *WmiT, *WmoT, *R1, *proj, *cn, *act;
    float *small, *mix, *y;
};

__device__ __forceinline__ void tr_item(const float* W, int ldsrc, int sc0, bf16* WT, int ldd, int dr0, int dc0, float scale, LAS float* scr, int kb, int nb, int lane) {
    const int k0 = 64 * kb, n0 = 32 * nb;
#pragma unroll 8
    for (int i = 0; i < 32; ++i) { const int kk = 2 * i + (lane >> 5); scr[kk * 33 + (lane & 31)] = W[(size_t)(k0 + kk) * ldsrc + sc0 + n0 + (lane & 31)]; }
    LDS_WAIT();
    const int c = lane & 7;
#pragma unroll
    for (int j = 0; j < 4; ++j) { const int n = (lane >> 3) + 8 * j; const LAS float* s = scr + (8 * c) * 33 + n;
        v4u o; o.x = pk2(s[0 * 33] * scale, s[1 * 33] * scale); o.y = pk2(s[2 * 33] * scale, s[3 * 33] * scale); o.z = pk2(s[4 * 33] * scale, s[5 * 33] * scale); o.w = pk2(s[6 * 33] * scale, s[7 * 33] * scale);
        *(v4u*)(WT + (size_t)(dr0 + n0 + n) * ldd + dc0 + k0 + 8 * c) = o; }
    LDS_WAIT();
}
__device__ __forceinline__ void rms_row_to_bf16(const float* xrow, const float* g, bf16* orow, int lane) {
    const f32x4* xr = (const f32x4*)xrow + lane; const f32x4* gr = (const f32x4*)g + lane;
    f32x4 v[4]; float s = 0.f;
#pragma unroll
    for (int j = 0; j < 4; ++j) { v[j] = xr[64 * j]; s += (v[j].x * v[j].x + v[j].y * v[j].y) + (v[j].z * v[j].z + v[j].w * v[j].w); }
    const float rstd = 1.0f / sqrtf(wave_sum(s) * (1.0f / DM) + EPS);
    unsigned long long* o8 = (unsigned long long*)orow + lane;
#pragma unroll
    for (int j = 0; j < 4; ++j) { const f32x4 gg = gr[64 * j];
        o8[64 * j] = (unsigned long long)pk2(v[j].x * rstd * gg.x, v[j].y * rstd * gg.y) | ((unsigned long long)pk2(v[j].z * rstd * gg.z, v[j].w * rstd * gg.w) << 32); }
}
__device__ __forceinline__ void p0_prologue(const Ctx& C) {
    LAS float* scr = (LAS float*)(C.lds + C.wave * 8704);
    const int lane = C.lane;
    for (int it = C.gw; it < 6496; it += C.NGW) {
        int r = it;
        if (r < 64)   { tr_item(C.w_in, INC, 512, C.WinT, DM, PC_CKV, 0, 1.f, scr, r / 4, r % 4, lane); continue; } r -= 64;
        if (r < 32)   { tr_item(C.w_in, INC, 1152, C.WinT, DM, PC_KIDX, 0, 1.f, scr, r / 2, r % 2, lane); continue; } r -= 32;
        if (r < 256)  { tr_item(C.w_in, INC, 640, C.WinT, DM, PC_QIDX, 0, 0.125f, scr, r / 16, r % 16, lane); continue; } r -= 256;
        if (r < 768)  { tr_item(C.w_in, INC, 1224, C.WinT, DM, PC_QB, 0, 1.f, scr, r / 48, r % 48, lane); continue; } r -= 768;
        if (r < 256)  { tr_item(C.w_in, INC, 2768, C.WinT, DM, PC_ZB, 0, 1.f, scr, r / 16, r % 16, lane); continue; } r -= 256;
        if (r < 256)  { tr_item(C.w_out + 512 * 1024, DM, 0, C.WoutT, KOUT, 0, 1024, 1.f, scr, r / 32, r % 32, lane); continue; } r -= 256;
        if (r < 2048) { tr_item(C.w_mi, DFF, 0, C.WmiT, DM, 0, 0, 1.f, scr, r / 128, r % 128, lane); continue; } r -= 2048;
        if (r < 2048) { tr_item(C.w_mo, DM, 0, C.WmoT, DFF, 0, 0, 1.f, scr, r / 32, r % 32, lane); continue; } r -= 2048;
        if (r < 512) {
            const int hh = r / 64, rem = r % 64, kblk = rem / 4, cq = rem % 4, k = kblk * 64 + lane;
            float wr[64]; const f32x4* src = (const f32x4*)(C.w_in + (size_t)k * INC + hh * 64);
#pragma unroll
            for (int i = 0; i < 16; ++i) { const f32x4 v = src[i]; wr[4 * i] = v.x; wr[4 * i + 1] = v.y; wr[4 * i + 2] = v.z; wr[4 * i + 3] = v.w; }
#pragma unroll 1
            for (int c = cq * 32; c < cq * 32 + 32; ++c) { const float* uk = C.w_uk + (size_t)(hh * 128 + c) * 64; float acc = 0.f;
#pragma unroll
                for (int d4 = 0; d4 < 4; ++d4) {
#pragma unroll
                    for (int d = 0; d < 16; ++d) acc += wr[d4 * 16 + d] * uk[d4 * 16 + d];
                    asm volatile("" ::: "memory"); }
                C.WinT[(size_t)(hh * 128 + c) * DM + k] = (bf16)f2bf(acc * 0.125f); }
            continue; } r -= 512;
        {
            const int hh = r / 32, rem = r % 32, cblk = rem / 16, nq = rem % 16, c = cblk * 64 + lane;
            float ur[64]; const f32x4* src = (const f32x4*)(C.w_uv + (size_t)(hh * 128 + c) * 64);
#pragma unroll
            for (int i = 0; i < 16; ++i) { const f32x4 v = src[i]; ur[4 * i] = v.x; ur[4 * i + 1] = v.y; ur[4 * i + 2] = v.z; ur[4 * i + 3] = v.w; }
#pragma unroll 1
            for (int n = nq * 64; n < nq * 64 + 64; ++n) { const float* wo = C.w_out + (size_t)(hh * 64) * DM + n; float acc = 0.f;
#pragma unroll
                for (int d4 = 0; d4 < 4; ++d4) {
#pragma unroll
                    for (int d = 0; d < 16; ++d) acc += ur[d4 * 16 + d] * wo[(size_t)(d4 * 16 + d) * DM];
                    asm volatile("" ::: "memory"); }
                C.WoutT[(size_t)n * KOUT + hh * 128 + c] = (bf16)f2bf(acc); }
        }
    }
    for (int i = blockIdx.x * 512 + C.tid; i < 64 * DM; i += C.G * 512) { const int r = i >> 10, k = i & 1023; float v = 0.f;
        if (r < 8) v = C.w_in[(size_t)k * INC + 1216 + r]; else if (r < 12) v = C.w_in[(size_t)k * INC + 2760 + (r - 8)]; else if (r < 16) v = C.w_in[(size_t)k * INC + 2764 + (r - 12)];
        C.WinT[(size_t)(PC_SMALL + r) * DM + k] = (bf16)f2bf(v); }
    for (int m = C.gw; m < MROWS; m += C.NGW) rms_row_to_bf16(C.x + (size_t)m * DM, C.g_pre_mix, C.R1 + (size_t)m * DM, lane);
}

__device__ __forceinline__ void p2_cn(const Ctx& C) {
    const int lane = C.lane; const float g0 = C.c_norm[2 * lane], g1 = C.c_norm[2 * lane + 1];
    for (int m = C.gw; m < MROWS; m += C.NGW) {
        const unsigned u = *(const unsigned*)(C.proj + (size_t)m * NPROJ + PC_CKV + 2 * lane); const float a = bflo(u), b = bfhi(u);
        const float r = 1.0f / sqrtf(wave_sum(a * a + b * b) * (1.0f / 128.f) + EPS);
        *(unsigned*)(C.cn + (size_t)m * 128 + 2 * lane) = pk2(a * r * g0, b * r * g1); }
}
__device__ __forceinline__ void p2_gdn_seq(const Ctx& C, int b, int h) {
    LAS float* qs = (LAS float*)C.lds; LAS float* ks = qs + 8192; LAS float* vs = ks + 8192; LAS float* ob = vs + 8192; LAS float* gl = ob + 8192; LAS float* bl = gl + 64;
    const int lane = C.lane, wave = C.wave, tid = C.tid;
    float S[128];
#pragma unroll
    for (int i = 0; i < 128; ++i) S[i] = 0.f;
    const float A = __expf(C.a_log[h]), dtb = C.dt_bias[h];
    const float on0 = C.o_norm[2 * lane], on1 = C.o_norm[2 * lane + 1];
    for (int chunk = 0; chunk < 32; ++chunk) {
        const int t0 = chunk * 64;
#pragma unroll 1
        for (int rr = 0; rr < 8; ++rr) { const int r = wave * 8 + rr, t = t0 + r;
#pragma unroll 1
            for (int X = 0; X < 3; ++X) { const int ch = X * 512 + h * 128 + 2 * lane; float a0 = 0.f, a1 = 0.f;
#pragma unroll
                for (int j = 0; j < 4; ++j) { const int tt = t - 3 + j;
                    if (tt >= 0) { const unsigned u = *(const unsigned*)(C.proj + (size_t)(b * SEQ + tt) * NPROJ + PC_QB + ch);
                        a0 += C.conv_w[j * 1536 + ch] * bflo(u); a1 += C.conv_w[j * 1536 + ch + 1] * bfhi(u); } }
                float y0 = silu_f(a0), y1 = silu_f(a1);
                if (X < 2) { const float rn = 1.0f / sqrtf(wave_sum(y0 * y0 + y1 * y1) + EPS); y0 *= rn; y1 *= rn; }
                if (X == 0) { y0 *= 0.08838834764831845f; y1 *= 0.08838834764831845f; }
                LAS float* dst = (X == 0 ? qs : X == 1 ? ks : vs) + r * 128 + 2 * lane; dst[0] = y0; dst[1] = y1; } }
        if (tid < 64) { const size_t m = (size_t)b * SEQ + t0 + tid; const float av = C.small[m * 16 + 8 + h], bv = C.small[m * 16 + 12 + h];
            gl[tid] = -A * softplus_f(av + dtb); bl[tid] = sigmoid_f(bv); }
        __syncthreads();
        if (tid < 128) {
#pragma unroll 1
            for (int t = 0; t < 64; ++t) { const float a = __expf(gl[t]), bt = bl[t]; const LAS float* kr = ks + t * 128; const LAS float* qr = qs + t * 128;
                float kS = 0.f;
#pragma unroll
                for (int d4 = 0; d4 < 8; ++d4) {
#pragma unroll
                    for (int d = 0; d < 16; ++d) kS += kr[d4 * 16 + d] * S[d4 * 16 + d];
                    asm volatile("" ::: "memory"); }
                const float dl = bt * (vs[t * 128 + tid] - a * kS); float o = 0.f;
#pragma unroll
                for (int d4 = 0; d4 < 8; ++d4) {
#pragma unroll
                    for (int d = 0; d < 16; ++d) { const int dd = d4 * 16 + d; S[dd] = a * S[dd] + kr[dd] * dl; o += qr[dd] * S[dd]; }
                    asm volatile("" ::: "memory"); }
                ob[t * 128 + tid] = o; } }
        __syncthreads();
#pragma unroll 1
        for (int rr = 0; rr < 8; ++rr) { const int r = wave * 8 + rr; const size_t m = (size_t)b * SEQ + t0 + r;
            const float o0 = ob[r * 128 + 2 * lane], o1 = ob[r * 128 + 2 * lane + 1];
            const float rstd = 1.0f / sqrtf(wave_sum(o0 * o0 + o1 * o1) * (1.0f / 128.f) + EPS);
            const unsigned zu = *(const unsigned*)(C.proj + m * NPROJ + PC_ZB + h * 128 + 2 * lane);
            *(unsigned*)(C.R1 + m * KOUT + 1024 + h * 128 + 2 * lane) = pk2(o0 * rstd * on0 * silu_f(bflo(zu)), o1 * rstd * on1 * silu_f(bfhi(zu))); }
        __syncthreads();
    }
}

__device__ __forceinline__ unsigned f2key(float f) { unsigned u = __float_as_uint(f); if (u == 0x80000000u) u = 0u; return (u & 0x80000000u) ? ~u : (u | 0x80000000u); }
__device__ __forceinline__ void p3_dsa_query(const Ctx& C, int b, int t, LAS unsigned char* wl) {
    const int lane = C.lane; const size_t m = (size_t)b * SEQ + t; const int N = ((t >> 6) + 1) << 6, ntile = N >> 6, nsel = N < 256 ? N : 256;
    LAS float* qi = (LAS float*)wl; LAS float* qa = qi + 512; LAS int* idx = (LAS int*)(qa + 1024); LAS unsigned* sc = (LAS unsigned*)(idx + 256); LAS float* pp = (LAS float*)sc;
    const bf16* prow = C.proj + m * NPROJ;
#pragma unroll
    for (int i = 0; i < 8; ++i) qi[i * 64 + lane] = bf2f(prow[PC_QIDX + i * 64 + lane]);
#pragma unroll
    for (int i = 0; i < 16; ++i) qa[i * 64 + lane] = bf2f(prow[PC_QABS + i * 64 + lane]);
    float wi[8];
#pragma unroll
    for (int hh = 0; hh < 8; ++hh) wi[hh] = C.small[m * 16 + hh] * 0.35355339059327373f;
    LDS_WAIT();
#pragma unroll 1
    for (int i = 0; i < ntile; ++i) { const int s = i * 64 + lane; const v4u* kr = (const v4u*)(C.proj + (size_t)(b * SEQ + s) * NPROJ + PC_KIDX);
        float kf[64];
#pragma unroll
        for (int j = 0; j < 8; ++j) { const v4u u = kr[j]; kf[8 * j] = bflo(u.x); kf[8 * j + 1] = bfhi(u.x); kf[8 * j + 2] = bflo(u.y); kf[8 * j + 3] = bfhi(u.y); kf[8 * j + 4] = bflo(u.z); kf[8 * j + 5] = bfhi(u.z); kf[8 * j + 6] = bflo(u.w); kf[8 * j + 7] = bfhi(u.w); }
        float score = 0.f;
#pragma unroll
        for (int hh = 0; hh < 8; ++hh) { float d = 0.f;
#pragma unroll
            for (int e = 0; e < 64; ++e) d += qi[hh * 64 + e] * kf[e];
            score += wi[hh] * fmaxf(d, 0.f); asm volatile("" ::: "memory"); }
        sc[s] = f2key(score); }
    LDS_WAIT();
    if (N <= 256) {
        for (int i = 0; i < ntile; ++i) idx[i * 64 + lane] = i * 64 + lane;
    } else {
        unsigned uk[32];
#pragma unroll
        for (int i = 0; i < 32; ++i) uk[i] = (i < ntile) ? sc[i * 64 + lane] : 0u;
        unsigned K = 0u;
#pragma unroll 1
        for (int bit = 31; bit >= 0; --bit) { const unsigned cand = K | (1u << bit); int cnt = 0;
#pragma unroll
            for (int i = 0; i < 32; ++i) if (i < ntile) cnt += __popcll(__ballot(uk[i] >= cand));
            if (cnt >= 256) K = cand; }
        int cgt = 0;
#pragma unroll
        for (int i = 0; i < 32; ++i) if (i < ntile) cgt += __popcll(__ballot(uk[i] > K));
        const int need = 256 - cgt; int base = 0, tie_seen = 0; const unsigned long long lt = (1ull << lane) - 1ull;
#pragma unroll
        for (int i = 0; i < 32; ++i) if (i < ntile) {
            const bool gt = uk[i] > K, eq = uk[i] == K; const unsigned long long mEq = __ballot(eq);
            const int rank_eq = tie_seen + __popcll(mEq & lt); const bool sel = gt || (eq && rank_eq < need);
            const unsigned long long mSel = __ballot(sel); const int pos = base + __popcll(mSel & lt);
            if (sel) idx[pos] = i * 64 + lane;
            base += __popcll(mSel); tie_seen += __popcll(mEq); }
    }
    LDS_WAIT();
#pragma unroll 1
    for (int jj = 0; jj < 4; ++jj) { const int j = jj * 64 + lane;
        if (j < nsel) { const int s = idx[j]; const v4u* cr = (const v4u*)(C.cn + (size_t)(b * SEQ + s) * 128);
            float acc[8];
#pragma unroll
            for (int hh = 0; hh < 8; ++hh) acc[hh] = 0.f;
#pragma unroll 1
            for (int cc = 0; cc < 16; ++cc) { const v4u u = cr[cc]; float cv[8]; cv[0] = bflo(u.x); cv[1] = bfhi(u.x); cv[2] = bflo(u.y); cv[3] = bfhi(u.y); cv[4] = bflo(u.z); cv[5] = bfhi(u.z); cv[6] = bflo(u.w); cv[7] = bfhi(u.w);
#pragma unroll
                for (int hh = 0; hh < 8; ++hh)
#pragma unroll
                    for (int e = 0; e < 8; ++e) acc[hh] += qa[hh * 128 + cc * 8 + e] * cv[e]; }
            const int bk = t5_bucket(s - t);
#pragma unroll
            for (int hh = 0; hh < 8; ++hh) pp[j * 8 + hh] = acc[hh] + C.rel_bias[bk * 8 + hh];
        } else {
#pragma unroll
            for (int hh = 0; hh < 8; ++hh) pp[j * 8 + hh] = -__builtin_inff();
        } }
    LDS_WAIT();
#pragma unroll
    for (int hh = 0; hh < 8; ++hh) { float v[4]; float mx = -__builtin_inff();
#pragma unroll
        for (int jj = 0; jj < 4; ++jj) { v[jj] = pp[(jj * 64 + lane) * 8 + hh]; mx = fmaxf(mx, v[jj]); }
        mx = wave_max(mx); float sm = 0.f;
#pragma unroll
        for (int jj = 0; jj < 4; ++jj) { v[jj] = __expf(v[jj] - mx); sm += v[jj]; }
        sm = 1.0f / wave_sum(sm);
#pragma unroll
        for (int jj = 0; jj < 4; ++jj) pp[(jj * 64 + lane) * 8 + hh] = v[jj] * sm; }
    LDS_WAIT();
    float o0[8], o1[8];
#pragma unroll
    for (int hh = 0; hh < 8; ++hh) { o0[hh] = 0.f; o1[hh] = 0.f; }
#pragma unroll 2
    for (int j = 0; j < nsel; ++j) { const int s = idx[j]; const unsigned u = *(const unsigned*)(C.cn + (size_t)(b * SEQ + s) * 128 + 2 * lane); const float c0 = bflo(u), c1 = bfhi(u);
        const f32x4 pa = *(const LAS f32x4*)(pp + j * 8), pb = *(const LAS f32x4*)(pp + j * 8 + 4);
        o0[0] += pa.x * c0; o1[0] += pa.x * c1; o0[1] += pa.y * c0; o1[1] += pa.y * c1; o0[2] += pa.z * c0; o1[2] += pa.z * c1; o0[3] += pa.w * c0; o1[3] += pa.w * c1;
        o0[4] += pb.x * c0; o1[4] += pb.x * c1; o0[5] += pb.y * c0; o1[5] += pb.y * c1; o0[6] += pb.z * c0; o1[6] += pb.z * c1; o0[7] += pb.w * c0; o1[7] += pb.w * c1; }
#pragma unroll
    for (int hh = 0; hh < 8; ++hh) *(unsigned*)(C.R1 + m * KOUT + hh * 128 + 2 * lane) = pk2(o0[hh], o1[hh]);
    LDS_WAIT();
}
__device__ __forceinline__ void p3_dsa(const Ctx& C) {
    LAS unsigned char* wl = C.lds + C.wave * 15360;
    for (int q = C.gw; q < MROWS; q += C.NGW) { const int b = q >> 11, t = ((q & 2047) + 128 * b) & 2047; p3_dsa_query(C, b, t, wl); }
}

__device__ __forceinline__ void p5_postnorm(const Ctx& C) {
    const int lane = C.lane;
    for (int m = C.gw; m < MROWS; m += C.NGW) {
        const f32x4* mr = (const f32x4*)(C.mix + (size_t)m * DM) + lane; const f32x4* xr = (const f32x4*)(C.x + (size_t)m * DM) + lane; f32x4* orow = (f32x4*)(C.out + (size_t)m * DM) + lane;
        const f32x4* g1 = (const f32x4*)C.g_post_mix + lane; const f32x4* g2 = (const f32x4*)C.g_pre_mlp + lane;
        f32x4 v[4]; float s = 0.f;
#pragma unroll
        for (int j = 0; j < 4; ++j) { v[j] = mr[64 * j]; s += (v[j].x * v[j].x + v[j].y * v[j].y) + (v[j].z * v[j].z + v[j].w * v[j].w); }
        const float rstd = 1.0f / sqrtf(wave_sum(s) * (1.0f / DM) + EPS); float s2 = 0.f;
#pragma unroll
        for (int j = 0; j < 4; ++j) { v[j] = xr[64 * j] + v[j] * rstd * g1[64 * j]; orow[64 * j] = v[j]; s2 += (v[j].x * v[j].x + v[j].y * v[j].y) + (v[j].z * v[j].z + v[j].w * v[j].w); }
        const float rstd2 = 1.0f / sqrtf(wave_sum(s2) * (1.0f / DM) + EPS);
        unsigned long long* o8 = (unsigned long long*)(C.R1 + (size_t)m * DM) + lane;
#pragma unroll
        for (int j = 0; j < 4; ++j) { const f32x4 gg = g2[64 * j];
            o8[64 * j] = (unsigned long long)pk2(v[j].x * rstd2 * gg.x, v[j].y * rstd2 * gg.y) | ((unsigned long long)pk2(v[j].z * rstd2 * gg.z, v[j].w * rstd2 * gg.w) << 32); }
    }
}
__device__ __forceinline__ void p8_final(const Ctx& C) {
    const int lane = C.lane;
    for (int m = C.gw; m < MROWS; m += C.NGW) {
        const f32x4* yr = (const f32x4*)(C.y + (size_t)m * DM) + lane; f32x4* orow = (f32x4*)(C.out + (size_t)m * DM) + lane; const f32x4* g1 = (const f32x4*)C.g_post_mlp + lane;
        f32x4 v[4]; float s = 0.f;
#pragma unroll
        for (int j = 0; j < 4; ++j) { v[j] = yr[64 * j]; s += (v[j].x * v[j].x + v[j].y * v[j].y) + (v[j].z * v[j].z + v[j].w * v[j].w); }
        const float rstd = 1.0f / sqrtf(wave_sum(s) * (1.0f / DM) + EPS);
#pragma unroll
        for (int j = 0; j < 4; ++j) orow[64 * j] = orow[64 * j] + v[j] * rstd * g1[64 * j];
    }
}

__global__ void __launch_bounds__(512, 2) fwd(Args a) {
    extern __shared__ __attribute__((aligned(16))) unsigned char lds_raw[];
    Ctx C;
    C.lds = (LAS unsigned char*)lds_raw;
    C.tid = threadIdx.x; C.lane = C.tid & 63; C.wave = __builtin_amdgcn_readfirstlane(C.tid >> 6); C.G = gridDim.x; C.gw = blockIdx.x * 8 + C.wave; C.NGW = C.G * 8;
    C.x = a.in[0]; C.w_in = a.in[1]; C.c_norm = a.in[2]; C.w_uk = a.in[3]; C.w_uv = a.in[4]; C.rel_bias = a.in[5]; C.conv_w = a.in[6]; C.a_log = a.in[7]; C.dt_bias = a.in[8]; C.o_norm = a.in[9];
    C.w_out = a.in[10]; C.g_pre_mix = a.in[11]; C.g_post_mix = a.in[12]; C.g_pre_mlp = a.in[13]; C.g_post_mlp = a.in[14]; C.w_mi = a.in[15]; C.w_mo = a.in[16]; C.out = a.out;
    unsigned char* ws = a.ws;
    C.WinT = (bf16*)(ws + WS_WIN); C.WoutT = (bf16*)(ws + WS_WOUT); C.WmiT = (bf16*)(ws + WS_WMI); C.WmoT = (bf16*)(ws + WS_WMO); C.R1 = (bf16*)(ws + WS_R1); C.proj = (bf16*)(ws + WS_PROJ);
    C.cn = (bf16*)(ws + WS_CN); C.act = (bf16*)(ws + WS_ACT); C.small = (float*)(ws + WS_SMALL); C.mix = (float*)(ws + WS_MIX); C.y = (float*)(ws + WS_Y);
    volatile LAS unsigned* MISC = (volatile LAS unsigned*)(C.lds + MISC_OFF);
    if (C.tid < 16) MISC[C.tid] = 0u;
    __syncthreads();
    const int lo = a.ph_lo, hi = a.ph_hi;
    XcdBarrier bar; bar.bar = (unsigned*)(ws + WS_CTL) + CW_BAR; bar.x = 0; bar.st = nullptr;
    if (hi - lo > 1) bar = xcd_barrier_post((unsigned*)(ws + WS_CTL) + CW_BAR, MISC);
#define IN(k) (lo <= (k) && (k) < hi)
#define SEAM(k) do { if (IN(k) && IN((k) + 1)) xcd_barrier(bar); } while (0)

#ifndef NO_P0
    if (IN(0)) { p0_prologue(C); SEAM(0); }
#endif
#ifndef NO_GEMM
    if (IN(1)) { pg8::Gemm g{C.R1, C.WinT, MROWS, NPROJ, DM}; pg8::StaticOrder S; S.init(MROWS, NPROJ, C.G, (int)blockIdx.x);
        pg8::EpiProj E{C.proj, NPROJ, C.small};
        pg8::gemm_phase<pg8::EpiProj, pg8::StaticOrder, false>(C.lds, g, S, E, nullptr); SEAM(1); }
#endif
#ifndef NO_P2
    if (IN(2)) { p2_cn(C); if (blockIdx.x < 64) p2_gdn_seq(C, blockIdx.x >> 2, blockIdx.x & 3); SEAM(2); }
#endif
#ifndef NO_P3
    if (IN(3)) { p3_dsa(C); SEAM(3); }
#endif
#ifndef NO_GEMM
    if (IN(4)) { pg8::Gemm g{C.R1, C.WoutT, MROWS, DM, KOUT}; pg8::StaticOrder S; S.init(MROWS, DM, C.G, (int)blockIdx.x);
        pg8::EpiF32 E{C.mix, DM, nullptr};
        pg8::gemm_phase<pg8::EpiF32, pg8::StaticOrder, false>(C.lds, g, S, E, nullptr); SEAM(4); }
#endif
    if (IN(5)) { p5_postnorm(C); SEAM(5); }
#ifndef NO_GEMM
    if (IN(6)) { pg8::Gemm g{C.R1, C.WmiT, MROWS, DFF, DM}; pg8::StaticOrder S; S.init(MROWS, DFF, C.G, (int)blockIdx.x);
        pg8::EpiRelu2 E{C.act, DFF};
        pg8::gemm_phase<pg8::EpiRelu2, pg8::StaticOrder, false>(C.lds, g, S, E, nullptr); SEAM(6); }
    if (IN(7)) { pg8::Gemm g{C.act, C.WmoT, MROWS, DM, DFF}; pg8::StaticOrder S; S.init(MROWS, DM, C.G, (int)blockIdx.x);
        pg8::EpiF32 E{C.y, DM, nullptr};
        pg8::gemm_phase<pg8::EpiF32, pg8::StaticOrder, false>(C.lds, g, S, E, nullptr); SEAM(7); }
#endif
    if (IN(8)) { p8_final(C); }
#undef IN
#undef SEAM
}

extern "C" void kernel_launch(void* const* d_in, const int* in_sizes, int n_in, void* d_out, int out_size, void* d_ws, size_t ws_size, hipStream_t stream) {
    static int grid = 0;
    if (grid == 0) {
        if (n_in != 17 || in_sizes[0] != MROWS * DM || out_size != MROWS * DM || ws_size < WS_END) {
            fprintf(stderr, "kernel_launch: built for 17 inputs, x/out of %d floats, >= %zu bytes of workspace; got n_in %d, in0 %d, out %d, ws %zu; nothing launched\n", MROWS * DM, (size_t)WS_END, n_in, n_in > 0 ? in_sizes[0] : -1, out_size, ws_size); grid = -1; return; }
        int dev = 0, cus = 0, per_cu = 0;
        if (hipGetDevice(&dev) != hipSuccess || hipDeviceGetAttribute(&cus, hipDeviceAttributeMultiprocessorCount, dev) != hipSuccess) { fprintf(stderr, "kernel_launch: device query failed\n"); grid = -1; return; }
        if (hipFuncSetAttribute((const void*)fwd, hipFuncAttributeMaxDynamicSharedMemorySize, LDS_BYTES) != hipSuccess) { fprintf(stderr, "kernel_launch: hipFuncSetAttribute failed\n"); grid = -1; return; }
        if (hipOccupancyMaxActiveBlocksPerMultiprocessor(&per_cu, (const void*)fwd, 512, LDS_BYTES) != hipSuccess || per_cu < 1)
            fprintf(stderr, "kernel_launch: note: occupancy query reports %d workgroups per CU\n", per_cu);
        (void)hipGetLastError();
        grid = cus;
        if (grid < 64) { fprintf(stderr, "kernel_launch: needs >= 64 CUs\n"); grid = -1; return; }
    }
    if (grid < 0) return;
    if (hipMemsetAsync((char*)d_ws + WS_CTL, 0, CTL_ZERO_BYTES, stream) != hipSuccess) { fprintf(stderr, "kernel_launch: memset failed\n"); return; }
    Args a{};
    for (int i = 0; i < 17; ++i) a.in[i] = (const float*)d_in[i];
    a.out = (float*)d_out; a.ws = (unsigned char*)d_ws;
    if (MK_N_LAUNCHES == 1) { a.ph_lo = 0; a.ph_hi = NPHASE; hipLaunchKernelGGL(fwd, dim3(grid), dim3(512), LDS_BYTES, stream, a); }
    else for (int p = 0; p < NPHASE; ++p) { a.ph_lo = p; a.ph_hi = p + 1; hipLaunchKernelGGL(fwd, dim3(grid), dim3(512), LDS_BYTES, stream, a); }
    const hipError_t le = hipPeekAtLastError();
    if (le != hipSuccess) fprintf(stderr, "kernel_launch: launch failed: %s\n", hipGetErrorName(le));
}
```

```cpp
#include <hip/hip_runtime.h>
#include <cstdio>
#include <cstdint>
namespace pg8 {
#define PG8_LAS __attribute__((address_space(3)))
typedef unsigned short bf16_t;
typedef short bf16x8 __attribute__((ext_vector_type(8)));
typedef float f32x4 __attribute__((ext_vector_type(4)));
typedef unsigned u32x4 __attribute__((ext_vector_type(4)));
constexpr int BM = 256, BK = 64, HALF = 128, HTB = HALF * BK * 2  , STAGE_BYTES = 8 * HTB, NXCD = 8, WGM = 8;

__host__ __device__ __forceinline__ int lds_byte(int r, int c) { const int st = (r >> 4) * 2 + (c >> 5), rr = r & 15, cc = c & 31, ob = rr * 64 + cc * 2; return st * 1024 + (ob ^ (((ob >> 9) & 1) << 5)); }
__host__ __device__ __forceinline__ void stage_rc(int b, int& R, int& C) { const int st = b / 1024, sb = b % 1024, swz = sb ^ (((sb >> 9) & 1) << 5); R = (st >> 1) * 16 + swz / 64; C = (st & 1) * 32 + (swz % 64) / 2; }
__host__ __device__ __forceinline__ int perm32(int rho) { const int n = rho >> 4, i = rho & 15; return 8 * (i >> 2) + 4 * n + (i & 3); }

struct Unit { int pm, pn; };
struct Gemm { const bf16_t* A; const bf16_t* Bt; int M, N, K; };

struct StaticOrder {
    int nM, nN, nwg, G, c;
    __host__ __device__ void init(int M, int N, int G_, int c_) { nM = M / BM; nN = N / BM; nwg = nM * nN; G = G_; c = c_; }
    __host__ __device__ bool next(int i, Unit& u) const {
        const long L = (long)i * G + c; if (L >= nwg) return false;
        int wgid = (int)L; { const int q = nwg / NXCD, r = nwg % NXCD, xcd = wgid % NXCD, off = wgid / NXCD; wgid = (xcd < r ? xcd * (q + 1) : r * (q + 1) + (xcd - r) * q) + off; }
        const int nig = WGM * nN, gid = wgid / nig, fm = gid * WGM, gsz = (nM - fm) < WGM ? (nM - fm) : WGM;
        u.pm = fm + ((wgid % nig) % gsz); u.pn = (wgid % nig) / gsz; return true;
    }
    __device__ __forceinline__ void a_ready(const Unit&) const {}
    __device__ __forceinline__ void done(const Unit&) const {}
};
__device__ __forceinline__ unsigned cvt_pk_bf16(float lo, float hi) { unsigned r; asm volatile("v_cvt_pk_bf16_f32 %0, %1, %2" : "=v"(r) : "v"(lo), "v"(hi)); return r; }
typedef float f32x2 __attribute__((ext_vector_type(2)));
struct EpiF32 {
    static constexpr bool PERM = false, AFTER_DRAIN = false;
    float* C; int ldc; const float* bias;
    __device__ __forceinline__ void operator()(const f32x4 (&acc)[2][2][4][2], const Unit& u, int wr, int wc, int fr, int fq) const {
        const int row0 = u.pm * BM + wr * 64 + fr, col0 = u.pn * BM + wc * 32 + 4 * fq;
        f32x4 bv[2][2];
#pragma unroll
        for (int bj = 0; bj < 2; ++bj)
#pragma unroll
            for (int n = 0; n < 2; ++n) bv[bj][n] = bias ? *(const f32x4*)(bias + col0 + bj * HALF + n * 16) : (f32x4){0.f, 0.f, 0.f, 0.f};
#pragma unroll
        for (int ai = 0; ai < 2; ++ai)
#pragma unroll
            for (int m = 0; m < 4; ++m) { float* rowp = C + (size_t)(row0 + ai * HALF + m * 16) * ldc + col0;
#pragma unroll
                for (int bj = 0; bj < 2; ++bj)
#pragma unroll
                    for (int n = 0; n < 2; ++n) *(f32x4*)(rowp + bj * HALF + n * 16) = acc[ai][bj][m][n] + bv[bj][n]; }
    }
};
struct EpiProj {
    static constexpr bool PERM = true, AFTER_DRAIN = false;
    bf16_t* O; int ldc; float* small;
    __device__ __forceinline__ void operator()(const f32x4 (&acc)[2][2][4][2], const Unit& u, int wr, int wc, int fr, int fq) const {
        const int row0 = u.pm * BM + wr * 64 + fr, col0 = u.pn * BM + wc * 32 + 8 * fq;
#pragma unroll
        for (int ai = 0; ai < 2; ++ai)
#pragma unroll
            for (int m = 0; m < 4; ++m) { bf16_t* rowp = O + (size_t)(row0 + ai * HALF + m * 16) * ldc + col0;
#pragma unroll
                for (int bj = 0; bj < 2; ++bj) { const f32x4 v0 = acc[ai][bj][m][0], v1 = acc[ai][bj][m][1];
                    u32x4 w; w.x = cvt_pk_bf16(v0[0], v0[1]); w.y = cvt_pk_bf16(v0[2], v0[3]); w.z = cvt_pk_bf16(v1[0], v1[1]); w.w = cvt_pk_bf16(v1[2], v1[3]);
                    *(u32x4*)(rowp + bj * HALF) = w; } }
        if (u.pn == 4 && wc == 2 && fq < 2) {
#pragma unroll
            for (int ai = 0; ai < 2; ++ai)
#pragma unroll
                for (int m = 0; m < 4; ++m) { float* sp = small + (size_t)(row0 + ai * HALF + m * 16) * 16 + 8 * fq;
                    *(f32x4*)sp = acc[ai][1][m][0]; *(f32x4*)(sp + 4) = acc[ai][1][m][1]; }
        }
    }
};
struct EpiRelu2 {
    static constexpr bool PERM = true, AFTER_DRAIN = false;
    bf16_t* O; int ldc;
    __device__ __forceinline__ void operator()(const f32x4 (&acc)[2][2][4][2], const Unit& u, int wr, int wc, int fr, int fq) const {
        const int row0 = u.pm * BM + wr * 64 + fr, col0 = u.pn * BM + wc * 32 + 8 * fq;
#pragma unroll
        for (int ai = 0; ai < 2; ++ai)
#pragma unroll
            for (int m = 0; m < 4; ++m) { bf16_t* rowp = O + (size_t)(row0 + ai * HALF + m * 16) * ldc + col0;
#pragma unroll
                for (int bj = 0; bj < 2; ++bj) { f32x4 v0 = acc[ai][bj][m][0], v1 = acc[ai][bj][m][1];
#pragma unroll
                    for (int j = 0; j < 4; ++j) { const float a = fmaxf(v0[j], 0.f), b = fmaxf(v1[j], 0.f); v0[j] = a * a; v1[j] = b * b; }
                    u32x4 w; w.x = cvt_pk_bf16(v0[0], v0[1]); w.y = cvt_pk_bf16(v0[2], v0[3]); w.z = cvt_pk_bf16(v1[0], v1[1]); w.w = cvt_pk_bf16(v1[2], v1[3]);
                    *(u32x4*)(rowp + bj * HALF) = w; } }
    }
};
template <class Epi, class Sched, bool STAMP = false>
__device__ __forceinline__ void gemm_phase(PG8_LAS unsigned char* lds, const Gemm g, const Sched& S, const Epi& E, unsigned long long* stamps) {
    const int tid = threadIdx.x, wid = __builtin_amdgcn_readfirstlane(tid >> 6), lane = tid & 63, wr = wid >> 2, wc = wid & 3, fr = lane & 15, fq = lane >> 4;
    const int K = g.K, nt = K / BK;
    int ts_lo = 0, ts_hi = 0, nts = 0; const unsigned long long rt_entry = STAMP ? (unsigned long long)wall_clock64() : 0ull;
#define PG8_STAMP() do { if (STAMP && wid == 0 && nts < 64) { const unsigned long long _c = (unsigned long long)clock64(); \
        ts_lo = (lane == nts) ? (int)(unsigned)_c : ts_lo; ts_hi = (lane == nts) ? (int)(unsigned)(_c >> 32) : ts_hi; ++nts; } } while (0)
    PG8_STAMP();
    unsigned voffA[2], voffB[2];
#pragma unroll
    for (int i = 0; i < 2; ++i) { int R, C; stage_rc(tid * 16 + i * 8192, R, C); const int Rb = Epi::PERM ? ((R & ~31) + perm32(R & 31)) : R;
        voffA[i] = (unsigned)(R * K + C) * 2u; voffB[i] = (unsigned)(Rb * K + C) * 2u; }
    const size_t kstep = (size_t)(BK * 2);
    const size_t hstep = (size_t)HALF * K * 2;
    const size_t tstep = 2 * hstep;
    const unsigned ldsw = (unsigned)wid * 1024u;
    const int aoff = lds_byte(wr * 64 + fr, fq * 8), boff = lds_byte(wc * 32 + fr, fq * 8);
#define PG8_SA(b, h) (((b) * 2 + (h)) * HTB)
#define PG8_SB(b, h) ((4 + (b) * 2 + (h)) * HTB)
#define PG8_STAGE(bufoff, gbase, voff) do { _Pragma("unroll") for (int _i = 0; _i < 2; ++_i) \
        __builtin_amdgcn_global_load_lds((const unsigned*)((const char*)(gbase) + (voff)[_i]), (PG8_LAS unsigned*)(lds + (bufoff) + ldsw + _i * 8192), 16, 0, 0); } while (0)
#define PG8_LDA(dst, b, h) do { _Pragma("unroll") for (int m = 0; m < 4; ++m) _Pragma("unroll") for (int k = 0; k < 2; ++k) dst[m][k] = *(const PG8_LAS bf16x8*)(lds + PG8_SA(b, h) + aoff + m * 2048 + k * 1024); } while (0)
#define PG8_LDB(dst, b, h) do { _Pragma("unroll") for (int n = 0; n < 2; ++n) _Pragma("unroll") for (int k = 0; k < 2; ++k) dst[n][k] = *(const PG8_LAS bf16x8*)(lds + PG8_SB(b, h) + boff + n * 2048 + k * 1024); } while (0)
#define PG8_MMA(ai, bj, At, Bt) do { __builtin_amdgcn_s_setprio(1); _Pragma("unroll") for (int m = 0; m < 4; ++m) _Pragma("unroll") for (int n = 0; n < 2; ++n) _Pragma("unroll") for (int k = 0; k < 2; ++k) \
        acc[ai][bj][m][n] = __builtin_amdgcn_mfma_f32_16x16x32_bf16(Bt[n][k], At[m][k], acc[ai][bj][m][n], 0, 0, 0); __builtin_amdgcn_s_setprio(0); } while (0)
#define PG8_WAIT_V(n) asm volatile("s_waitcnt vmcnt(" #n ")" ::: "memory")
#define PG8_WAIT_L(n) asm volatile("s_waitcnt lgkmcnt(" #n ")" ::: "memory")
#define PG8_BAR __builtin_amdgcn_s_barrier()
#define PG8_SCHED __builtin_amdgcn_sched_barrier(0)
    Unit cur, nxt; int ui = 0;
    if (!S.next(0, cur)) return;
    f32x4 acc[2][2][4][2];
#pragma unroll
    for (int a = 0; a < 2; ++a)
#pragma unroll
        for (int b = 0; b < 2; ++b)
#pragma unroll
            for (int m = 0; m < 4; ++m)
#pragma unroll
                for (int n = 0; n < 2; ++n) acc[a][b][m][n] = (f32x4){0.f, 0.f, 0.f, 0.f};
    bf16x8 At[4][2], B0[2][2], B1[2][2];
    const char* cA = (const char*)g.A + (size_t)cur.pm * tstep; const char* cB = (const char*)g.Bt + (size_t)cur.pn * tstep;
    S.a_ready(cur);
    PG8_STAGE(PG8_SB(0, 0), cB, voffB); PG8_STAGE(PG8_SA(0, 0), cA, voffA); PG8_STAGE(PG8_SB(0, 1), cB + hstep, voffB); PG8_STAGE(PG8_SA(0, 1), cA + hstep, voffA);
    if (wr == 1) PG8_BAR;
    PG8_WAIT_V(4); PG8_BAR;
    PG8_STAGE(PG8_SB(1, 0), cB + kstep, voffB); PG8_STAGE(PG8_SA(1, 0), cA + kstep, voffA); PG8_STAGE(PG8_SB(1, 1), cB + hstep + kstep, voffB);
    PG8_WAIT_V(6); PG8_BAR;
    PG8_STAMP();
    for (;;) {
        const bool has_next = S.next(ui + 1, nxt);
        const char* nA = has_next ? (const char*)g.A + (size_t)nxt.pm * tstep : cA; const char* nB = has_next ? (const char*)g.Bt + (size_t)nxt.pn * tstep : cB;
        for (int t = 0; t < nt; t += 2) {
            const bool last = (t == nt - 2);
            const char* a1 = cA + (size_t)(t + 1) * kstep;
            const char* a2 = last ? nA : cA + (size_t)(t + 2) * kstep; const char* b2 = last ? nB : cB + (size_t)(t + 2) * kstep;
            const char* a3 = a2 + kstep; const char* b3 = b2 + kstep;
            if (last && has_next) S.a_ready(nxt);
            PG8_LDB(B0, 0, 0); PG8_SCHED; PG8_LDA(At, 0, 0); PG8_STAGE(PG8_SA(1, 1), a1 + hstep, voffA);
            PG8_WAIT_L(8); PG8_BAR; PG8_WAIT_L(0); PG8_MMA(0, 0, At, B0); PG8_BAR; PG8_SCHED;
            PG8_LDB(B1, 0, 1); PG8_STAGE(PG8_SB(0, 0), b2, voffB);
            PG8_BAR; PG8_WAIT_L(0); PG8_MMA(0, 1, At, B1); PG8_BAR;
            PG8_LDA(At, 0, 1); PG8_STAGE(PG8_SA(0, 0), a2, voffA);
            PG8_BAR; PG8_WAIT_L(0); PG8_MMA(1, 0, At, B0); PG8_BAR; PG8_SCHED;
            PG8_STAGE(PG8_SB(0, 1), b2 + hstep, voffB);
            PG8_WAIT_V(6); PG8_BAR; PG8_MMA(1, 1, At, B1); PG8_BAR;
            PG8_LDB(B0, 1, 0); PG8_SCHED; PG8_LDA(At, 1, 0); PG8_STAGE(PG8_SA(0, 1), a2 + hstep, voffA);
            PG8_WAIT_L(8); PG8_BAR; PG8_WAIT_L(0); PG8_MMA(0, 0, At, B0); PG8_BAR; PG8_SCHED;
            PG8_LDB(B1, 1, 1); PG8_STAGE(PG8_SB(1, 0), b3, voffB);
            PG8_BAR; PG8_WAIT_L(0); PG8_MMA(0, 1, At, B1); PG8_BAR;
            PG8_LDA(At, 1, 1); PG8_STAGE(PG8_SA(1, 0), a3, voffA);
            PG8_BAR; PG8_WAIT_L(0); PG8_MMA(1, 0, At, B0); PG8_BAR; PG8_SCHED;
            PG8_STAGE(PG8_SB(1, 1), b3 + hstep, voffB);
            PG8_WAIT_V(6); PG8_BAR; PG8_MMA(1, 1, At, B1); PG8_BAR;
        }
        PG8_STAMP();
        if constexpr (!Epi::AFTER_DRAIN) { E(acc, cur, wr, wc, fr, fq); S.done(cur); }
        PG8_STAMP();
        if (!has_next) break;
#pragma unroll
        for (int a = 0; a < 2; ++a)
#pragma unroll
            for (int b = 0; b < 2; ++b)
#pragma unroll
                for (int m = 0; m < 4; ++m)
#pragma unroll
                    for (int n = 0; n < 2; ++n) acc[a][b][m][n] = (f32x4){0.f, 0.f, 0.f, 0.f};
        cur = nxt; cA = nA; cB = nB; ++ui;
    }
    PG8_WAIT_V(0);
    if (wr == 0) PG8_BAR;
    PG8_BAR;
    if constexpr (Epi::AFTER_DRAIN) { E.fused(acc, cur, wr, wc, fr, fq, lds, wid, lane); S.done(cur); }
    PG8_STAMP();
    if (STAMP && wid == 0) { stamps[lane] = lane < nts ? (((unsigned long long)(unsigned)ts_hi << 32) | (unsigned)ts_lo) : 0ull;
        if (lane == 62) stamps[62] = rt_entry; if (lane == 63) stamps[63] = (unsigned long long)wall_clock64(); }
#undef PG8_STAMP
#undef PG8_SA
#undef PG8_SB
#undef PG8_STAGE
#undef PG8_LDA
#undef PG8_LDB
#undef PG8_MMA
#undef PG8_WAIT_V
#undef PG8_WAIT_L
#undef PG8_BAR
#undef PG8_SCHED
}
}
#define XB_TMO      128
#define XB_XCNT(j)  (256  + 64 * (j))
#define XB_XSUB(j)  (1280 + 64 * (j))
#define XB_XGEN(j)  (2304 + 64 * (j))
#define XB_TOP      3328
#define XB_TOPGEN   3392
#define XCD_BAR_WORDS 3456
#define XB_SPIN_CAP (1u << 18)
#define LAS __attribute__((address_space(3)))

__device__ __forceinline__ unsigned xb_ld(unsigned* p)              { return __hip_atomic_load(p, __ATOMIC_RELAXED, __HIP_MEMORY_SCOPE_AGENT); }
__device__ __forceinline__ unsigned xb_add(unsigned* p, unsigned v) { return __hip_atomic_fetch_add(p, v, __ATOMIC_RELAXED, __HIP_MEMORY_SCOPE_AGENT); }
__device__ __forceinline__ unsigned xb_xcc_id() { return (unsigned)__builtin_amdgcn_s_getreg((3 << 11) | 20) & 0xFu; }
#define XB_SPIN(cond, bar) do { unsigned _sp = 0; while (cond) { __builtin_amdgcn_s_sleep(1); \
    if ((++_sp & 255u) == 0u) { if (xb_ld(&(bar)[XB_TMO])) break; if (_sp > XB_SPIN_CAP) { atomicAdd(&(bar)[XB_TMO], 1u); break; } } } } while (0)

struct XcdBarrier {
    unsigned* bar; unsigned x;
    volatile LAS unsigned* st;
};

__device__ __forceinline__ XcdBarrier xcd_barrier_post(unsigned* bar, volatile LAS unsigned* st) {
    XcdBarrier b; b.bar = bar; b.x = xb_xcc_id(); b.st = st;
    if (threadIdx.x == 0) (void)xb_add(&bar[XB_XCNT(b.x)], 1u);
    return b;
}
__device__ __forceinline__ void xcd_barrier_complete(unsigned* bar, unsigned x, unsigned& nloc, unsigned& nx) {
    const unsigned G = gridDim.x * gridDim.y * gridDim.z;
    unsigned sum, cnt, mine, sp = 0u;
    for (;;) {
        sum = 0u; cnt = 0u; mine = 0u;
#pragma unroll
        for (unsigned j = 0; j < 16; ++j) { const unsigned c = xb_ld(&bar[XB_XCNT(j)]); sum += c; cnt += (c > 0u) ? 1u : 0u; mine = (j == x) ? c : mine; }
        if (sum == G) break;
        __builtin_amdgcn_s_sleep(1);
        if ((++sp & 255u) == 0u) { if (xb_ld(&bar[XB_TMO])) break; if (sp > XB_SPIN_CAP) { atomicAdd(&bar[XB_TMO], 1u); break; } }
    }
    nloc = mine > 0u ? mine : 1u; nx = cnt > 0u ? cnt : 1u;
}

__device__ __forceinline__ void xcd_barrier(const XcdBarrier& b) {
    asm volatile("s_waitcnt vmcnt(0)" ::: "memory");
    __syncthreads();
    if (threadIdx.x == 0) {
        unsigned* bar = b.bar;
        __builtin_amdgcn_s_waitcnt(0);
        unsigned nloc = b.st[0], nx = b.st[1];
        if (nloc == 0u) { xcd_barrier_complete(bar, b.x, nloc, nx); b.st[0] = nloc; b.st[1] = nx; }
        const unsigned old = xb_add(&bar[XB_XSUB(b.x)], 1u);
        const unsigned gen = old / nloc;
        if (old + 1u == (gen + 1u) * nloc) {
            __builtin_amdgcn_fence(__ATOMIC_RELEASE, "agent");
            asm volatile("s_waitcnt vmcnt(0)" ::: "memory");
            const unsigned og = xb_add(&bar[XB_TOP], 1u);
            const unsigned tg = og / nx;
            if (og + 1u == (tg + 1u) * nx) xb_add(&bar[XB_TOPGEN], 1u);
            else XB_SPIN(xb_ld(&bar[XB_TOPGEN]) == tg, bar);
            __builtin_amdgcn_fence(__ATOMIC_ACQUIRE, "agent");
            xb_add(&bar[XB_XGEN(b.x)], 1u);
            asm volatile("s_waitcnt vmcnt(0)" ::: "memory");
        } else {
            XB_SPIN(xb_ld(&bar[XB_XGEN(b.x)]) == gen, bar);
            __builtin_amdgcn_fence(__ATOMIC_ACQUIRE, "agent");
            asm volatile("s_waitcnt vmcnt(0)" ::: "memory");
        }
    }
    __syncthreads();
}
#ifndef MK_N_LAUNCHES
#define MK_N_LAUNCHES 1
#endif
constexpr int NPHASE = 9;
constexpr int BATCH = 16, SEQ = 2048, DM = 1024, MROWS = BATCH * SEQ, NPROJ = 3840, DFF = 4096, KOUT = 1536, INC = 3280;
constexpr float EPS = 1e-6f;
constexpr int PC_QABS = 0, PC_CKV = 1024, PC_KIDX = 1152, PC_SMALL = 1216, PC_QIDX = 1280, PC_QB = 1792, PC_KB = 2304, PC_VB = 2816, PC_ZB = 3328;
constexpr size_t MiB = 1u << 20;
constexpr size_t WS_CTL = 0, CTL_ZERO_BYTES = 1 * MiB;
constexpr size_t WS_WMI = 1 * MiB, WS_WMO = 9 * MiB, WS_R1 = 17 * MiB, WS_WOUT = 113 * MiB, WS_WIN = 116 * MiB, WS_SMALL = 124 * MiB, WS_CN = 126 * MiB, WS_PROJ = 134 * MiB;
constexpr size_t WS_MIX = 134 * MiB, WS_ACT = 116 * MiB, WS_Y = 372 * MiB, WS_END = 500 * MiB;
constexpr int CW_BAR = 4096;
constexpr int LDS_BYTES = 147456, MISC_OFF = LDS_BYTES - 64;

typedef unsigned short bf16;
typedef unsigned v4u __attribute__((ext_vector_type(4)));
typedef float f32x4 __attribute__((ext_vector_type(4)));
typedef float f32x2 __attribute__((ext_vector_type(2)));
#define LDS_WAIT() asm volatile("s_waitcnt lgkmcnt(0)" ::: "memory")
__device__ __forceinline__ unsigned f2bf(float f) { unsigned u = __float_as_uint(f); return (u + 0x7fffu + ((u >> 16) & 1u)) >> 16; }
__device__ __forceinline__ unsigned pk2(float lo, float hi) { return f2bf(lo) | (f2bf(hi) << 16); }
__device__ __forceinline__ float bflo(unsigned u) { return __uint_as_float(u << 16); }
__device__ __forceinline__ float bfhi(unsigned u) { return __uint_as_float(u & 0xffff0000u); }
__device__ __forceinline__ float bf2f(bf16 b) { return __uint_as_float(((unsigned)b) << 16); }
__device__ __forceinline__ float wave_sum(float v) {
#pragma unroll
    for (int o = 1; o < 64; o <<= 1) v += __shfl_xor(v, o);
    return v;
}
__device__ __forceinline__ float wave_max(float v) {
#pragma unroll
    for (int o = 1; o < 64; o <<= 1) v = fmaxf(v, __shfl_xor(v, o));
    return v;
}
__device__ __forceinline__ float silu_f(float x) { return x / (1.0f + __expf(-x)); }
__device__ __forceinline__ float sigmoid_f(float x) { return 1.0f / (1.0f + __expf(-x)); }
__device__ __forceinline__ float softplus_f(float x) { return fmaxf(x, 0.f) + log1pf(__expf(-fabsf(x))); }
__device__ __forceinline__ int t5_bucket(int rel) {
    const int side = rel > 0 ? 16 : 0, n = rel < 0 ? -rel : rel;
    int bk;
    if (n < 8) bk = n; else bk = 8 + (n >= 12) + (n >= 16) + (n >= 23) + (n >= 32) + (n >= 46) + (n >= 64) + (n >= 91);
    return side + bk;
}

struct Args { const float* in[17]; float* out; unsigned char* ws; int ph_lo, ph_hi; };
struct Ctx {
    int tid, lane, wave, G, gw, NGW;
    LAS unsigned char* lds;
    const float *x, *w_in, *c_norm, *w_uk, *w_uv, *rel_bias, *conv_w, *a_log, *dt_bias, *o_norm, *w_out, *g_pre_mix, *g_post_mix, *g_pre_mlp, *g_post_mlp, *w_mi, *w_mo;
    float* out;
    bf16 *WinT, *WoutT, *WmiT, *WmoT, *R1, *proj, *cn, *act;
    float *small, *mix, *y;
};

__device__ __forceinline__ void tr_item(const float* W, int ldsrc, int sc0, bf16* WT, int ldd, int dr0, int dc0, float scale, LAS float* scr, int kb, int nb, int lane) {
    const int k0 = 64 * kb, n0 = 32 * nb;
#pragma unroll 8
    for (int i = 0; i < 32; ++i) { const int kk = 2 * i + (lane >> 5); scr[kk * 33 + (lane & 31)] = W[(size_t)(k0 + kk) * ldsrc + sc0 + n0 + (lane & 31)]; }
    LDS_WAIT();
    const int c = lane & 7;
#pragma unroll
    for (int j = 0; j < 4; ++j) { const int n = (lane >> 3) + 8 * j; const LAS float* s = scr + (8 * c) * 33 + n;
        v4u o; o.x = pk2(s[0 * 33] * scale, s[1 * 33] * scale); o.y = pk2(s[2 * 33] * scale, s[3 * 33] * scale); o.z = pk2(s[4 * 33] * scale, s[5 * 33] * scale); o.w = pk2(s[6 * 33] * scale, s[7 * 33] * scale);
        *(v4u*)(WT + (size_t)(dr0 + n0 + n) * ldd + dc0 + k0 + 8 * c) = o; }
    LDS_WAIT();
}
__device__ __forceinline__ void rms_row_to_bf16(const float* xrow, const float* g, bf16* orow, int lane) {
    const f32x4* xr = (const f32x4*)xrow + lane; const f32x4* gr = (const f32x4*)g + lane;
    f32x4 v[4]; float s = 0.f;
#pragma unroll
    for (int j = 0; j < 4; ++j) { v[j] = xr[64 * j]; s += (v[j].x * v[j].x + v[j].y * v[j].y) + (v[j].z * v[j].z + v[j].w * v[j].w); }
    const float rstd = 1.0f / sqrtf(wave_sum(s) * (1.0f / DM) + EPS);
    unsigned long long* o8 = (unsigned long long*)orow + lane;
#pragma unroll
    for (int j = 0; j < 4; ++j) { const f32x4 gg = gr[64 * j];
        o8[64 * j] = (unsigned long long)pk2(v[j].x * rstd * gg.x, v[j].y * rstd * gg.y) | ((unsigned long long)pk2(v[j].z * rstd * gg.z, v[j].w * rstd * gg.w) << 32); }
}
__device__ __forceinline__ void p0_prologue(const Ctx& C) {
    LAS float* scr = (LAS float*)(C.lds + C.wave * 8704);
    const int lane = C.lane;
    for (int it = C.gw; it < 6496; it += C.NGW) {
        int r = it;
        if (r < 64)   { tr_item(C.w_in, INC, 512, C.WinT, DM, PC_CKV, 0, 1.f, scr, r / 4, r % 4, lane); continue; } r -= 64;
        if (r < 32)   { tr_item(C.w_in, INC, 1152, C.WinT, DM, PC_KIDX, 0, 1.f, scr, r / 2, r % 2, lane); continue; } r -= 32;
        if (r < 256)  { tr_item(C.w_in, INC, 640, C.WinT, DM, PC_QIDX, 0, 0.125f, scr, r / 16, r % 16, lane); continue; } r -= 256;
        if (r < 768)  { tr_item(C.w_in, INC, 1224, C.WinT, DM, PC_QB, 0, 1.f, scr, r / 48, r % 48, lane); continue; } r -= 768;
        if (r < 256)  { tr_item(C.w_in, INC, 2768, C.WinT, DM, PC_ZB, 0, 1.f, scr, r / 16, r % 16, lane); continue; } r -= 256;
        if (r < 256)  { tr_item(C.w_out + 512 * 1024, DM, 0, C.WoutT, KOUT, 0, 1024, 1.f, scr, r / 32, r % 32, lane); continue; } r -= 256;
        if (r < 2048) { tr_item(C.w_mi, DFF, 0, C.WmiT, DM, 0, 0, 1.f, scr, r / 128, r % 128, lane); continue; } r -= 2048;
        if (r < 2048) { tr_item(C.w_mo, DM, 0, C.WmoT, DFF, 0, 0, 1.f, scr, r / 32, r % 32, lane); continue; } r -= 2048;
        if (r < 512) {
            const int hh = r / 64, rem = r % 64, kblk = rem / 4, cq = rem % 4, k = kblk * 64 + lane;
            float wr[64]; const f32x4* src = (const f32x4*)(C.w_in + (size_t)k * INC + hh * 64);
#pragma unroll
            for (int i = 0; i < 16; ++i) { const f32x4 v = src[i]; wr[4 * i] = v.x; wr[4 * i + 1] = v.y; wr[4 * i + 2] = v.z; wr[4 * i + 3] = v.w; }
#pragma unroll 1
            for (int c = cq * 32; c < cq * 32 + 32; ++c) { const float* uk = C.w_uk + (size_t)(hh * 128 + c) * 64; float acc = 0.f;
#pragma unroll
                for (int d4 = 0; d4 < 4; ++d4) {
#pragma unroll
                    for (int d = 0; d < 16; ++d) acc += wr[d4 * 16 + d] * uk[d4 * 16 + d];
                    asm volatile("" ::: "memory"); }
                C.WinT[(size_t)(hh * 128 + c) * DM + k] = (bf16)f2bf(acc * 0.125f); }
            continue; } r -= 512;
        {
            const int hh = r / 32, rem = r % 32, cblk = rem / 16, nq = rem % 16, c = cblk * 64 + lane;
            float ur[64]; const f32x4* src = (const f32x4*)(C.w_uv + (size_t)(hh * 128 + c) * 64);
#pragma unroll
            for (int i = 0; i < 16; ++i) { const f32x4 v = src[i]; ur[4 * i] = v.x; ur[4 * i + 1] = v.y; ur[4 * i + 2] = v.z; ur[4 * i + 3] = v.w; }
#pragma unroll 1
            for (int n = nq * 64; n < nq * 64 + 64; ++n) { const float* wo = C.w_out + (size_t)(hh * 64) * DM + n; float acc = 0.f;
#pragma unroll
                for (int d4 = 0; d4 < 4; ++d4) {
#pragma unroll
                    for (int d = 0; d < 16; ++d) acc += ur[d4 * 16 + d] * wo[(size_t)(d4 * 16 + d) * DM];
                    asm volatile("" ::: "memory"); }
                C.WoutT[(size_t)n * KOUT + hh * 128 + c] = (bf16)f2bf(acc); }
        }
    }
    for (int i = blockIdx.x * 512 + C.tid; i < 64 * DM; i += C.G * 512) { const int r = i >> 10, k = i & 1023; float v = 0.f;
        if (r < 8) v = C.w_in[(size_t)k * INC + 1216 + r]; else if (r < 12) v = C.w_in[(size_t)k * INC + 2760 + (r - 8)]; else if (r < 16) v = C.w_in[(size_t)k * INC + 2764 + (r - 12)];
        C.WinT[(size_t)(PC_SMALL + r) * DM + k] = (bf16)f2bf(v); }
    for (int m = C.gw; m < MROWS; m += C.NGW) rms_row_to_bf16(C.x + (size_t)m * DM, C.g_pre_mix, C.R1 + (size_t)m * DM, lane);
}

__device__ __forceinline__ void p2_cn(const Ctx& C) {
    const int lane = C.lane; const float g0 = C.c_norm[2 * lane], g1 = C.c_norm[2 * lane + 1];
    for (int m = C.gw; m < MROWS; m += C.NGW) {
        const unsigned u = *(const unsigned*)(C.proj + (size_t)m * NPROJ + PC_CKV + 2 * lane); const float a = bflo(u), b = bfhi(u);
        const float r = 1.0f / sqrtf(wave_sum(a * a + b * b) * (1.0f / 128.f) + EPS);
        *(unsigned*)(C.cn + (size_t)m * 128 + 2 * lane) = pk2(a * r * g0, b * r * g1); }
}
__device__ __forceinline__ void p2_gdn_seq(const Ctx& C, int b, int h) {
    LAS float* qs = (LAS float*)C.lds; LAS float* ks = qs + 8192; LAS float* vs = ks + 8192; LAS float* ob = vs + 8192; LAS float* gl = ob + 8192; LAS float* bl = gl + 64;
    const int lane = C.lane, wave = C.wave, tid = C.tid;
    float S[128];
#pragma unroll
    for (int i = 0; i < 128; ++i) S[i] = 0.f;
    const float A = __expf(C.a_log[h]), dtb = C.dt_bias[h];
    const float on0 = C.o_norm[2 * lane], on1 = C.o_norm[2 * lane + 1];
    for (int chunk = 0; chunk < 32; ++chunk) {
        const int t0 = chunk * 64;
#pragma unroll 1
        for (int rr = 0; rr < 8; ++rr) { const int r = wave * 8 + rr, t = t0 + r;
#pragma unroll 1
            for (int X = 0; X < 3; ++X) { const int ch = X * 512 + h * 128 + 2 * lane; float a0 = 0.f, a1 = 0.f;
#pragma unroll
                for (int j = 0; j < 4; ++j) { const int tt = t - 3 + j;
                    if (tt >= 0) { const unsigned u = *(const unsigned*)(C.proj + (size_t)(b * SEQ + tt) * NPROJ + PC_QB + ch);
                        a0 += C.conv_w[j * 1536 + ch] * bflo(u); a1 += C.conv_w[j * 1536 + ch + 1] * bfhi(u); } }
                float y0 = silu_f(a0), y1 = silu_f(a1);
                if (X < 2) { const float rn = 1.0f / sqrtf(wave_sum(y0 * y0 + y1 * y1) + EPS); y0 *= rn; y1 *= rn; }
                if (X == 0) { y0 *= 0.08838834764831845f; y1 *= 0.08838834764831845f; }
                LAS float* dst = (X == 0 ? qs : X == 1 ? ks : vs) + r * 128 + 2 * lane; dst[0] = y0; dst[1] = y1; } }
        if (tid < 64) { const size_t m = (size_t)b * SEQ + t0 + tid; const float av = C.small[m * 16 + 8 + h], bv = C.small[m * 16 + 12 + h];
            gl[tid] = -A * softplus_f(av + dtb); bl[tid] = sigmoid_f(bv); }
        __syncthreads();
        if (tid < 128) {
#pragma unroll 1
            for (int t = 0; t < 64; ++t) { const float a = __expf(gl[t]), bt = bl[t]; const LAS float* kr = ks + t * 128; const LAS float* qr = qs + t * 128;
                float kS = 0.f;
#pragma unroll
                for (int d4 = 0; d4 < 8; ++d4) {
#pragma unroll
                    for (int d = 0; d < 16; ++d) kS += kr[d4 * 16 + d] * S[d4 * 16 + d];
                    asm volatile("" ::: "memory"); }
                const float dl = bt * (vs[t * 128 + tid] - a * kS); float o = 0.f;
#pragma unroll
                for (int d4 = 0; d4 < 8; ++d4) {
#pragma unroll
                    for (int d = 0; d < 16; ++d) { const int dd = d4 * 16 + d; S[dd] = a * S[dd] + kr[dd] * dl; o += qr[dd] * S[dd]; }
                    asm volatile("" ::: "memory"); }
                ob[t * 128 + tid] = o; } }
        __syncthreads();
#pragma unroll 1
        for (int rr = 0; rr < 8; ++rr) { const int r = wave * 8 + rr; const size_t m = (size_t)b * SEQ + t0 + r;
            const float o0 = ob[r * 128 + 2 * lane], o1 = ob[r * 128 + 2 * lane + 1];
            const float rstd = 1.0f / sqrtf(wave_sum(o0 * o0 + o1 * o1) * (1.0f / 128.f) + EPS);
            const unsigned zu = *(const unsigned*)(C.proj + m * NPROJ + PC_ZB + h * 128 + 2 * lane);
            *(unsigned*)(C.R1 + m * KOUT + 1024 + h * 128 + 2 * lane) = pk2(o0 * rstd * on0 * silu_f(bflo(zu)), o1 * rstd * on1 * silu_f(bfhi(zu))); }
        __syncthreads();
    }
}

__device__ __forceinline__ unsigned f2key(float f) { unsigned u = __float_as_uint(f); if (u == 0x80000000u) u = 0u; return (u & 0x80000000u) ? ~u : (u | 0x80000000u); }
__device__ __forceinline__ void p3_dsa_query(const Ctx& C, int b, int t, LAS unsigned char* wl) {
    const int lane = C.lane; const size_t m = (size_t)b * SEQ + t; const int N = ((t >> 6) + 1) << 6, ntile = N >> 6, nsel = N < 256 ? N : 256;
    LAS float* qi = (LAS float*)wl; LAS float* qa = qi + 512; LAS int* idx = (LAS int*)(qa + 1024); LAS unsigned* sc = (LAS unsigned*)(idx + 256); LAS float* pp = (LAS float*)sc;
    const bf16* prow = C.proj + m * NPROJ;
#pragma unroll
    for (int i = 0; i < 8; ++i) qi[i * 64 + lane] = bf2f(prow[PC_QIDX + i * 64 + lane]);
#pragma unroll
    for (int i = 0; i < 16; ++i) qa[i * 64 + lane] = bf2f(prow[PC_QABS + i * 64 + lane]);
    float wi[8];
#pragma unroll
    for (int hh = 0; hh < 8; ++hh) wi[hh] = C.small[m * 16 + hh] * 0.35355339059327373f;
    LDS_WAIT();
#pragma unroll 1
    for (int i = 0; i < ntile; ++i) { const int s = i * 64 + lane; const v4u* kr = (const v4u*)(C.proj + (size_t)(b * SEQ + s) * NPROJ + PC_KIDX);
        float kf[64];
#pragma unroll
        for (int j = 0; j < 8; ++j) { const v4u u = kr[j]; kf[8 * j] = bflo(u.x); kf[8 * j + 1] = bfhi(u.x); kf[8 * j + 2] = bflo(u.y); kf[8 * j + 3] = bfhi(u.y); kf[8 * j + 4] = bflo(u.z); kf[8 * j + 5] = bfhi(u.z); kf[8 * j + 6] = bflo(u.w); kf[8 * j + 7] = bfhi(u.w); }
        float score = 0.f;
#pragma unroll
        for (int hh = 0; hh < 8; ++hh) { float d = 0.f;
#pragma unroll
            for (int e = 0; e < 64; ++e) d += qi[hh * 64 + e] * kf[e];
            score += wi[hh] * fmaxf(d, 0.f); asm volatile("" ::: "memory"); }
        sc[s] = f2key(score); }
    LDS_WAIT();
    if (N <= 256) {
        for (int i = 0; i < ntile; ++i) idx[i * 64 + lane] = i * 64 + lane;
    } else {
        unsigned uk[32];
#pragma unroll
        for (int i = 0; i < 32; ++i) uk[i] = (i < ntile) ? sc[i * 64 + lane] : 0u;
        unsigned K = 0u;
#pragma unroll 1
        for (int bit = 31; bit >= 0; --bit) { const unsigned cand = K | (1u << bit); int cnt = 0;
#pragma unroll
            for (int i = 0; i < 32; ++i) if (i < ntile) cnt += __popcll(__ballot(uk[i] >= cand));
            if (cnt >= 256) K = cand; }
        int cgt = 0;
#pragma unroll
        for (int i = 0; i < 32; ++i) if (i < ntile) cgt += __popcll(__ballot(uk[i] > K));
        const int need = 256 - cgt; int base = 0, tie_seen = 0; const unsigned long long lt = (1ull << lane) - 1ull;
#pragma unroll
        for (int i = 0; i < 32; ++i) if (i < ntile) {
            const bool gt = uk[i] > K, eq = uk[i] == K; const unsigned long long mEq = __ballot(eq);
            const int rank_eq = tie_seen + __popcll(mEq & lt); const bool sel = gt || (eq && rank_eq < need);
            const unsigned long long mSel = __ballot(sel); const int pos = base + __popcll(mSel & lt);
            if (sel) idx[pos] = i * 64 + lane;
            base += __popcll(mSel); tie_seen += __popcll(mEq); }
    }
    LDS_WAIT();
#pragma unroll 1
    for (int jj = 0; jj < 4; ++jj) { const int j = jj * 64 + lane;
        if (j < nsel) { const int s = idx[j]; const v4u* cr = (const v4u*)(C.cn + (size_t)(b * SEQ + s) * 128);
            float acc[8];
#pragma unroll
            for (int hh = 0; hh < 8; ++hh) acc[hh] = 0.f;
#pragma unroll 1
            for (int cc = 0; cc < 16; ++cc) { const v4u u = cr[cc]; float cv[8]; cv[0] = bflo(u.x); cv[1] = bfhi(u.x); cv[2] = bflo(u.y); cv[3] = bfhi(u.y); cv[4] = bflo(u.z); cv[5] = bfhi(u.z); cv[6] = bflo(u.w); cv[7] = bfhi(u.w);
#pragma unroll
                for (int hh = 0; hh < 8; ++hh)
#pragma unroll
                    for (int e = 0; e < 8; ++e) acc[hh] += qa[hh * 128 + cc * 8 + e] * cv[e]; }
            const int bk = t5_bucket(s - t);
#pragma unroll
            for (int hh = 0; hh < 8; ++hh) pp[j * 8 + hh] = acc[hh] + C.rel_bias[bk * 8 + hh];
        } else {
#pragma unroll
            for (int hh = 0; hh < 8; ++hh) pp[j * 8 + hh] = -__builtin_inff();
        } }
    LDS_WAIT();
#pragma unroll
    for (int hh = 0; hh < 8; ++hh) { float v[4]; float mx = -__builtin_inff();
#pragma unroll
        for (int jj = 0; jj < 4; ++jj) { v[jj] = pp[(jj * 64 + lane) * 8 + hh]; mx = fmaxf(mx, v[jj]); }
        mx = wave_max(mx); float sm = 0.f;
#pragma unroll
        for (int jj = 0; jj < 4; ++jj) { v[jj] = __expf(v[jj] - mx); sm += v[jj]; }
        sm = 1.0f / wave_sum(sm);
#pragma unroll
        for (int jj = 0; jj < 4; ++jj) pp[(jj * 64 + lane) * 8 + hh] = v[jj] * sm; }
    LDS_WAIT();
    float o0[8], o1[8];
#pragma unroll
    for (int hh = 0; hh < 8; ++hh) { o0[hh] = 0.f; o1[hh] = 0.f; }
#pragma unroll 2
    for (int j = 0; j < nsel; ++j) { const int s = idx[j]; const unsigned u = *(const unsigned*)(C.cn + (size_t)(b * SEQ + s) * 128 + 2 * lane); const float c0 = bflo(u), c1 = bfhi(u);
        const f32x4 pa = *(const LAS f32x4*)(pp + j * 8), pb = *(const LAS f32x4*)(pp + j * 8 + 4);
        o0[0] += pa.x * c0; o1[0] += pa.x * c1; o0[1] += pa.y * c0; o1[1] += pa.y * c1; o0[2] += pa.z * c0; o1[2] += pa.z * c1; o0[3] += pa.w * c0; o1[3] += pa.w * c1;
        o0[4] += pb.x * c0; o1[4] += pb.x * c1; o0[5] += pb.y * c0; o1[5] += pb.y * c1; o0[6] += pb.z * c0; o1[6] += pb.z * c1; o0[7] += pb.w * c0; o1[7] += pb.w * c1; }
#pragma unroll
    for (int hh = 0; hh < 8; ++hh) *(unsigned*)(C.R1 + m * KOUT + hh * 128 + 2 * lane) = pk2(o0[hh], o1[hh]);
    LDS_WAIT();
}
__device__ __forceinline__ void p3_dsa(const Ctx& C) {
    LAS unsigned char* wl = C.lds + C.wave * 15360;
    for (int q = C.gw; q < MROWS; q += C.NGW) { const int b = q >> 11, t = ((q & 2047) + 128 * b) & 2047; p3_dsa_query(C, b, t, wl); }
}

__device__ __forceinline__ void p5_postnorm(const Ctx& C) {
    const int lane = C.lane;
    for (int m = C.gw; m < MROWS; m += C.NGW) {
        const f32x4* mr = (const f32x4*)(C.mix + (size_t)m * DM) + lane; const f32x4* xr = (const f32x4*)(C.x + (size_t)m * DM) + lane; f32x4* orow = (f32x4*)(C.out + (size_t)m * DM) + lane;
        const f32x4* g1 = (const f32x4*)C.g_post_mix + lane; const f32x4* g2 = (const f32x4*)C.g_pre_mlp + lane;
        f32x4 v[4]; float s = 0.f;
#pragma unroll
        for (int j = 0; j < 4; ++j) { v[j] = mr[64 * j]; s += (v[j].x * v[j].x + v[j].y * v[j].y) + (v[j].z * v[j].z + v[j].w * v[j].w); }
        const float rstd = 1.0f / sqrtf(wave_sum(s) * (1.0f / DM) + EPS); float s2 = 0.f;
#pragma unroll
        for (int j = 0; j < 4; ++j) { v[j] = xr[64 * j] + v[j] * rstd * g1[64 * j]; orow[64 * j] = v[j]; s2 += (v[j].x * v[j].x + v[j].y * v[j].y) + (v[j].z * v[j].z + v[j].w * v[j].w); }
        const float rstd2 = 1.0f / sqrtf(wave_sum(s2) * (1.0f / DM) + EPS);
        unsigned long long* o8 = (unsigned long long*)(C.R1 + (size_t)m * DM) + lane;
#pragma unroll
        for (int j = 0; j < 4; ++j) { const f32x4 gg = g2[64 * j];
            o8[64 * j] = (unsigned long long)pk2(v[j].x * rstd2 * gg.x, v[j].y * rstd2 * gg.y) | ((unsigned long long)pk2(v[j].z * rstd2 * gg.z, v[j].w * rstd2 * gg.w) << 32); }
    }
}
__device__ __forceinline__ void p8_final(const Ctx& C) {
    const int lane = C.lane;
    for (int m = C.gw; m < MROWS; m += C.NGW) {
        const f32x4* yr = (const f32x4*)(C.y + (size_t)m * DM) + lane; f32x4* orow = (f32x4*)(C.out + (size_t)m * DM) + lane; const f32x4* g1 = (const f32x4*)C.g_post_mlp + lane;
        f32x4 v[4]; float s = 0.f;
#pragma unroll
        for (int j = 0; j < 4; ++j) { v[j] = yr[64 * j]; s += (v[j].x * v[j].x + v[j].y * v[j].y) + (v[j].z * v[j].z + v[j].w * v[j].w); }
        const float rstd = 1.0f / sqrtf(wave_sum(s) * (1.0f / DM) + EPS);
#pragma unroll
        for (int j = 0; j < 4; ++j) orow[64 * j] = orow[64 * j] + v[j] * rstd * g1[64 * j];
    }
}

namespace dsa {
using bf16x8 = __attribute__((ext_vector_type(8))) short;
using s16x4  = __attribute__((ext_vector_type(4))) short;
using f32x16 = __attribute__((ext_vector_type(16))) float;
using f32x4v = __attribute__((ext_vector_type(4))) float;
using u32x4  = __attribute__((ext_vector_type(4))) unsigned;
typedef unsigned long long u64;
constexpr int KVB = 16384;
constexpr int OFF_V = 0, OFF_K = 2 * KVB, OFF_WS = 4 * KVB, OFF_BIAS = OFF_WS + 8 * 256, BIAS_N = 288, BIAS_Z = 224, OFF_MASK = 132096;
constexpr float THR = 8.f;
#define KSWZ(row, colB) ((row) * 256 + ((colB) ^ (((row) & 7) << 4)))
#define SBAR() __builtin_amdgcn_sched_barrier(0)
__device__ __forceinline__ int crow(int r, int hi) { return (r & 3) + 8 * (r >> 2) + 4 * hi; }
__device__ __forceinline__ unsigned cvtpk(float lo, float hi) { unsigned r; asm volatile("v_cvt_pk_bf16_f32 %0, %1, %2" : "=v"(r) : "v"(lo), "v"(hi)); return r; }
__device__ __forceinline__ float maskf(float p, unsigned w, int c) { const int m = ((int)(w << (31 - c))) >> 31; return __uint_as_float(__float_as_uint(p) & (unsigned)m); }

__device__ __forceinline__ void partialSM(f32x16& p0, f32x16& p1, float& m_reg, float& mn, float& alpha, float badd, unsigned mlo) {
  constexpr float C = 1.4426950408889634f;
  float pmax = p0[0];
#pragma unroll
  for (int r = 1; r < 16; ++r) pmax = fmaxf(pmax, p0[r]);
#pragma unroll
  for (int r = 0; r < 16; ++r) pmax = fmaxf(pmax, p1[r]);
  { auto rr = __builtin_amdgcn_permlane32_swap(__float_as_uint(pmax), __float_as_uint(pmax), false, false);
    pmax = fmaxf(__uint_as_float(rr[0]), __uint_as_float(rr[1])); }
  pmax += badd;
  if (__builtin_expect(__all(pmax - m_reg <= THR), 1)) { mn = m_reg; alpha = 1.f; }
  else { mn = fmaxf(m_reg, pmax); alpha = __builtin_amdgcn_exp2f((m_reg - mn) * C); m_reg = mn; }
  const float mnC = (badd - mn) * C;
#pragma unroll
  for (int r = 0; r < 16; ++r) p0[r] = fmaf(p0[r], C, mnC);
#pragma unroll
  for (int r = 0; r < 16; ++r) p1[r] = fmaf(p1[r], C, mnC);
#pragma unroll
  for (int r = 0; r < 16; ++r) p0[r] = maskf(__builtin_amdgcn_exp2f(p0[r]), mlo, (r & 3) + 8 * (r >> 2));
}
__device__ __forceinline__ void finishSM(f32x16& p0, f32x16& p1, float alpha, float& l_reg, bf16x8& pa0, bf16x8& pa1, bf16x8& pa2, bf16x8& pa3, unsigned mhi) {
#pragma unroll
  for (int r = 0; r < 16; ++r) p1[r] = maskf(__builtin_amdgcn_exp2f(p1[r]), mhi, (r & 3) + 8 * (r >> 2));
  float ps = 0;
#pragma unroll
  for (int r = 0; r < 16; ++r) ps += p0[r];
#pragma unroll
  for (int r = 0; r < 16; ++r) ps += p1[r];
  { auto rr = __builtin_amdgcn_permlane32_swap(__float_as_uint(ps), __float_as_uint(ps), false, false);
    ps = __uint_as_float(rr[0]) + __uint_as_float(rr[1]); }
  l_reg = l_reg * alpha + ps;
#define PK4(P, BASE, OUT) do { unsigned a0 = cvtpk(P[BASE + 0], P[BASE + 1]), a1 = cvtpk(P[BASE + 2], P[BASE + 3]);   \
    unsigned b0 = cvtpk(P[BASE + 4], P[BASE + 5]), b1 = cvtpk(P[BASE + 6], P[BASE + 7]);                              \
    auto r0 = __builtin_amdgcn_permlane32_swap(a0, b0, false, false); auto r1 = __builtin_amdgcn_permlane32_swap(a1, b1, false, false); \
    u32x4 w = {r0[0], r1[0], r0[1], r1[1]}; OUT = *reinterpret_cast<bf16x8*>(&w); } while (0)
  PK4(p0, 0, pa0); PK4(p0, 8, pa1); PK4(p1, 0, pa2); PK4(p1, 8, pa3);
#undef PK4
}
__device__ __forceinline__ void qkt(f32x16& p0, f32x16& p1, const LAS char* Ks, const bf16x8* qr, int r32, int hi) {
  p0 = f32x16{}; p1 = f32x16{};
#pragma unroll
  for (int d0 = 0; d0 < 8; ++d0) { const int cb = (d0 * 16 + hi * 8) * 2;
    const bf16x8 b0 = *reinterpret_cast<const LAS bf16x8*>(Ks + KSWZ(r32, cb));
    const bf16x8 b1 = *reinterpret_cast<const LAS bf16x8*>(Ks + KSWZ(32 + r32, cb));
    p0 = __builtin_amdgcn_mfma_f32_32x32x16_bf16(b0, qr[d0], p0, 0, 0, 0);
    p1 = __builtin_amdgcn_mfma_f32_32x32x16_bf16(b1, qr[d0], p1, 0, 0, 0); }
}
__device__ __forceinline__ int v_st(int k, int c) { const int kk = (k & ~0xC) | ((k & 4) << 1) | ((k & 8) >> 1); return ((kk >> 3) * 4 + (c >> 5)) * 512 + ((kk & 7) * 32 + (c & 31)) * 2; }
__device__ __forceinline__ int v_rd_base(int lane) { return ((lane & 3) << 3) | (((lane >> 2) & 3) << 6) | (((lane >> 4) & 1) << 5) | (((lane >> 5) & 1) << 8); }
constexpr int v_rd_off(int d0, int ks, int half) { return d0 * 512 + ks * 4096 + half * 2048; }
template <int OFF> __device__ __forceinline__ s16x4 tr_read(int vb) {
  s16x4 r; asm volatile("ds_read_b64_tr_b16 %0, %1 offset:%2" : "=&v"(r) : "v"(vb), "i"(OFF) : "memory"); return r;
}
template <int D0> __device__ __forceinline__ void pv_one(f32x16& od, int vb, bf16x8 pa0, bf16x8 pa1, bf16x8 pa2, bf16x8 pa3) {
  const s16x4 l0 = tr_read<v_rd_off(D0, 0, 0)>(vb), h0 = tr_read<v_rd_off(D0, 0, 1)>(vb), l1 = tr_read<v_rd_off(D0, 1, 0)>(vb), h1 = tr_read<v_rd_off(D0, 1, 1)>(vb);
  const s16x4 l2 = tr_read<v_rd_off(D0, 2, 0)>(vb), h2 = tr_read<v_rd_off(D0, 2, 1)>(vb), l3 = tr_read<v_rd_off(D0, 3, 0)>(vb), h3 = tr_read<v_rd_off(D0, 3, 1)>(vb);
  asm volatile("s_waitcnt lgkmcnt(0)" ::: "memory"); SBAR();
#define PK(L, H) (bf16x8){L[0], L[1], L[2], L[3], H[0], H[1], H[2], H[3]}
  od = __builtin_amdgcn_mfma_f32_32x32x16_bf16(pa0, PK(l0, h0), od, 0, 0, 0);
  od = __builtin_amdgcn_mfma_f32_32x32x16_bf16(pa1, PK(l1, h1), od, 0, 0, 0);
  od = __builtin_amdgcn_mfma_f32_32x32x16_bf16(pa2, PK(l2, h2), od, 0, 0, 0);
  od = __builtin_amdgcn_mfma_f32_32x32x16_bf16(pa3, PK(l3, h3), od, 0, 0, 0);
#undef PK
}
__device__ __forceinline__ void pv_d0(f32x16* o, int vb, bf16x8 pa0, bf16x8 pa1, bf16x8 pa2, bf16x8 pa3) {
  pv_one<0>(o[0], vb, pa0, pa1, pa2, pa3); pv_one<1>(o[1], vb, pa0, pa1, pa2, pa3); pv_one<2>(o[2], vb, pa0, pa1, pa2, pa3); pv_one<3>(o[3], vb, pa0, pa1, pa2, pa3);
}

__device__ __forceinline__ void attn_item(const Ctx& C, int b, int q0, int N) {
  const int tid = C.tid, wid = C.wave, lane = C.lane, r32 = lane & 31, hi = lane >> 5;
  const int NT = N >> 6;
  LAS char* V_lds = (LAS char*)C.lds + OFF_V; LAS char* K_lds = (LAS char*)C.lds + OFF_K;
  LAS float* wsp = (LAS float*)(C.lds + OFF_WS) + wid * 64; LAS float* li_l = wsp; LAS float* al_l = wsp + 32;
  const LAS float* btab = (const LAS float*)(C.lds + OFF_BIAS) + wid * BIAS_N;
  const LAS u64* mrow = (const LAS u64*)(C.lds + OFF_MASK) + r32 * 32;
  const float b15 = C.rel_bias[15 * 8 + wid];
  float m_reg = -1e30f, l_reg = 0.f; f32x16 o[4] = {}; bf16x8 qr[8];
  const bf16* Qw = C.proj + (size_t)(b * SEQ + q0 + r32) * NPROJ + PC_QABS + wid * 128 + hi * 8;
#pragma unroll
  for (int d0 = 0; d0 < 8; ++d0) qr[d0] = *reinterpret_cast<const bf16x8*>(Qw + d0 * 16);
  const int sr = tid >> 4, sc = (tid & 15) * 8, vst0 = v_st(sr, sc), vst1 = v_st(32 + sr, sc), kst0 = KSWZ(sr, sc * 2), kst1 = KSWZ(32 + sr, sc * 2);
  const int vb0 = (int)(unsigned)(size_t)V_lds + v_rd_base(lane);
  const bf16* Cb = C.cn + (size_t)b * SEQ * 128 + sc;
  bf16x8 sA0, sA1;
#define SLOAD(S0, S1, k0) do { S0 = *reinterpret_cast<const bf16x8*>(Cb + (size_t)((k0) + sr) * 128); S1 = *reinterpret_cast<const bf16x8*>(Cb + (size_t)((k0) + 32 + sr) * 128); } while (0)
#define SWRITE(bf, S0, S1) do { *reinterpret_cast<LAS bf16x8*>(V_lds + (bf) * KVB + vst0) = S0; *reinterpret_cast<LAS bf16x8*>(V_lds + (bf) * KVB + vst1) = S1; \
    *reinterpret_cast<LAS bf16x8*>(K_lds + (bf) * KVB + kst0) = S0; *reinterpret_cast<LAS bf16x8*>(K_lds + (bf) * KVB + kst1) = S1; } while (0)
#define SWAIT() asm volatile("s_waitcnt vmcnt(2)" ::: "memory")
#define RESC(a) do { if (__any((a) < 1.f)) { if (hi == 0) al_l[r32] = (a); asm volatile("s_waitcnt lgkmcnt(0)" ::: "memory"); \
    _Pragma("unroll") for (int d = 0; d < 4; ++d) _Pragma("unroll") for (int r = 0; r < 16; ++r) o[d][r] *= al_l[crow(r, hi)]; } } while (0)
#define SCORE(P0, P1, bf, jt, BADD, MW) do { qkt(P0, P1, K_lds + (bf) * KVB, qr, r32, hi); MW = mrow[(jt)]; \
    if ((jt) < NT && 64 * (jt) + 63 - q0 > -128) { const LAS float* tb = btab + (64 * (jt) - q0 - r32 + BIAS_Z + 4 * hi); BADD = 0.f; \
      _Pragma("unroll") for (int r = 0; r < 16; ++r) { const int c = (r & 3) + 8 * (r >> 2); P0[r] += tb[c]; P1[r] += tb[32 + c]; } } \
    else BADD = b15; } while (0)
#define MLO(MW) (((unsigned)(MW)) >> (4 * hi))
#define MHI(MW) (((unsigned)((MW) >> 32)) >> (4 * hi))
  f32x16 pA0, pA1; float mnA, alA, bdA; u64 mwA; bf16x8 pa0, pa1, pa2, pa3;
  SLOAD(sA0, sA1, 0); asm volatile("s_waitcnt vmcnt(0)" ::: "memory"); SWRITE(0, sA0, sA1); __syncthreads();
  if (1 < NT) SLOAD(sA0, sA1, 64);
#pragma unroll 1
  for (int jt = 0; jt < NT; ++jt) { const int cur = jt & 1;
    SBAR(); SCORE(pA0, pA1, cur, jt, bdA, mwA);
    partialSM(pA0, pA1, m_reg, mnA, alA, bdA, MLO(mwA));
    RESC(alA);
    finishSM(pA0, pA1, alA, l_reg, pa0, pa1, pa2, pa3, MHI(mwA)); SBAR();
    pv_d0(o, vb0 + cur * KVB, pa0, pa1, pa2, pa3);
    if (jt + 1 < NT) { SWRITE(cur ^ 1, sA0, sA1); if (jt + 2 < NT) SLOAD(sA0, sA1, (jt + 2) * 64); }
    __syncthreads();
  }
  if (hi == 0) li_l[r32] = l_reg; asm volatile("s_waitcnt lgkmcnt(0)" ::: "memory");
  float rli[16];
#pragma unroll
  for (int r = 0; r < 16; ++r) rli[r] = __builtin_amdgcn_rcpf(li_l[crow(r, hi)]);
  bf16* Ow = C.R1 + (size_t)(b * SEQ + q0) * KOUT + wid * 128;
#pragma unroll
  for (int r = 0; r < 16; ++r) { const int orow = crow(r, hi);
#pragma unroll
    for (int d0 = 0; d0 < 4; ++d0) Ow[(size_t)orow * KOUT + d0 * 32 + r32] = (bf16)f2bf(o[d0][r] * rli[r]); }
#undef SLOAD
#undef SWRITE
#undef SWAIT
#undef RESC
#undef SCORE
#undef MLO
#undef MHI
}

__device__ __forceinline__ void scores16(const Ctx& C, int b, int q0g, int N) {
  const int lane = C.lane, lq = lane & 15, g = lane >> 4, wave = C.wave;
  LAS float* sc = (LAS float*)C.lds;
  const bf16* prow = C.proj + (size_t)(b * SEQ + q0g + lq) * NPROJ + PC_QIDX + g * 8;
  bf16x8 bq[8][2]; float wv[8];
#pragma unroll
  for (int hh = 0; hh < 8; ++hh) { bq[hh][0] = *reinterpret_cast<const bf16x8*>(prow + hh * 64); bq[hh][1] = *reinterpret_cast<const bf16x8*>(prow + hh * 64 + 32);
    wv[hh] = C.small[(size_t)(b * SEQ + q0g + lq) * 16 + hh] * 0.35355339059327373f; }
  const int nt16 = N >> 4;
  const bf16* kbase = C.proj + (size_t)(b * SEQ + lq) * NPROJ + PC_KIDX + g * 8;
  bf16x8 a0, a1, n0, n1;
  if (wave < nt16) { const bf16* kr = kbase + (size_t)(16 * wave) * NPROJ; n0 = *reinterpret_cast<const bf16x8*>(kr); n1 = *reinterpret_cast<const bf16x8*>(kr + 32); }
  for (int j = wave; j < nt16; j += 8) {
    a0 = n0; a1 = n1;
    if (j + 8 < nt16) { const bf16* kr = kbase + (size_t)(16 * (j + 8)) * NPROJ; n0 = *reinterpret_cast<const bf16x8*>(kr); n1 = *reinterpret_cast<const bf16x8*>(kr + 32); }
    f32x4v acc[8];
#pragma unroll
    for (int hh = 0; hh < 8; ++hh) acc[hh] = __builtin_amdgcn_mfma_f32_16x16x32_bf16(a0, bq[hh][0], (f32x4v){0.f, 0.f, 0.f, 0.f}, 0, 0, 0);
#pragma unroll
    for (int hh = 0; hh < 8; ++hh) acc[hh] = __builtin_amdgcn_mfma_f32_16x16x32_bf16(a1, bq[hh][1], acc[hh], 0, 0, 0);
    f32x4v s4 = {0.f, 0.f, 0.f, 0.f};
#pragma unroll
    for (int hh = 0; hh < 8; ++hh)
#pragma unroll
      for (int r = 0; r < 4; ++r) s4[r] += wv[hh] * fmaxf(acc[hh][r], 0.f);
    *reinterpret_cast<LAS f32x4v*>(sc + lq * (N + 4) + 16 * j + 4 * g) = s4;
  }
}
__device__ __forceinline__ void select16(const Ctx& C, int grp, int N) {
  const int lane = C.lane, NT = N >> 6;
  const LAS float* sc = (const LAS float*)C.lds; LAS u64* mask = (LAS u64*)(C.lds + OFF_MASK);
#pragma unroll 1
  for (int qq = 2 * C.wave; qq < 2 * C.wave + 2; ++qq) {
    const LAS float* row = sc + qq * (N + 4);
    unsigned uk[32];
#pragma unroll
    for (int i = 0; i < 32; ++i) uk[i] = (i < NT) ? f2key(row[i * 64 + lane]) : 0u;
    unsigned K = 0u; bool exact = false;
#pragma unroll 1
    for (int bit = 31; bit >= 0; --bit) { const unsigned cand = K | (1u << bit); int cnt = 0;
#pragma unroll
      for (int i = 0; i < 32; ++i) if (i < NT) cnt += __popcll(__ballot(uk[i] >= cand));
      if (cnt >= 256) { K = cand; if (cnt == 256) { exact = true; break; } } }
    LAS u64* mq = mask + (grp * 16 + qq) * 32;
    if (exact) {
#pragma unroll
      for (int i = 0; i < 32; ++i) if (i < NT) { const u64 m = __ballot(uk[i] >= K); if (lane == 0) mq[i] = m; }
    } else {
      int cgt = 0;
#pragma unroll
      for (int i = 0; i < 32; ++i) if (i < NT) cgt += __popcll(__ballot(uk[i] > K));
      const int need = 256 - cgt; int tie_seen = 0; const u64 lt = (1ull << lane) - 1ull;
#pragma unroll
      for (int i = 0; i < 32; ++i) if (i < NT) {
        const bool gt = uk[i] > K, eq = uk[i] == K; const u64 mEq = __ballot(eq);
        const int rank_eq = tie_seen + __popcll(mEq & lt); const bool sel = gt || (eq && rank_eq < need);
        const u64 m = __ballot(sel); if (lane == 0) mq[i] = m;
        tie_seen += __popcll(mEq); }
    }
    if (lane == 0 && NT < 32) mq[NT] = 0ull;
  }
}
__device__ __forceinline__ void dsa_item(const Ctx& C, int b, int qb) {
  const int q0 = qb * 32, N = ((qb >> 1) + 1) * 64, NT = N >> 6, tid = C.tid;
  LAS u64* mask = (LAS u64*)(C.lds + OFF_MASK);
  if (N <= 256) {
    for (int i = tid; i < 32 * 32; i += 512) mask[i] = ((i & 31) < NT) ? ~0ull : 0ull;
  } else {
#pragma unroll 1
    for (int grp = 0; grp < 2; ++grp) { scores16(C, b, q0 + 16 * grp, N); __syncthreads(); select16(C, grp, N); __syncthreads(); }
  }
  { LAS float* bt = (LAS float*)(C.lds + OFF_BIAS);
    for (int i = tid; i < 8 * BIAS_N; i += 512) { const int hh = i / BIAS_N, e = i % BIAS_N; bt[i] = C.rel_bias[t5_bucket(e - BIAS_Z) * 8 + hh]; } }
  __syncthreads();
  attn_item(C, b, q0, N);
  __syncthreads();
}
__device__ __forceinline__ void p3_dsa_mfma(const Ctx& C) {
  for (int pi = blockIdx.x; pi < 512; pi += C.G) { const int b = pi >> 5, pr = pi & 31;
    dsa_item(C, b, 63 - pr); dsa_item(C, b, pr); }
}
#undef KSWZ
#undef SBAR
}
__global__ void __launch_bounds__(512, 2) fwd(Args a) {
    extern __shared__ __attribute__((aligned(16))) unsigned char lds_raw[];
    Ctx C;
    C.lds = (LAS unsigned char*)lds_raw;
    C.tid = threadIdx.x; C.lane = C.tid & 63; C.wave = __builtin_amdgcn_readfirstlane(C.tid >> 6); C.G = gridDim.x; C.gw = blockIdx.x * 8 + C.wave; C.NGW = C.G * 8;
    C.x = a.in[0]; C.w_in = a.in[1]; C.c_norm = a.in[2]; C.w_uk = a.in[3]; C.w_uv = a.in[4]; C.rel_bias = a.in[5]; C.conv_w = a.in[6]; C.a_log = a.in[7]; C.dt_bias = a.in[8]; C.o_norm = a.in[9];
    C.w_out = a.in[10]; C.g_pre_mix = a.in[11]; C.g_post_mix = a.in[12]; C.g_pre_mlp = a.in[13]; C.g_post_mlp = a.in[14]; C.w_mi = a.in[15]; C.w_mo = a.in[16]; C.out = a.out;
    unsigned char* ws = a.ws;
    C.WinT = (bf16*)(ws + WS_WIN); C.WoutT = (bf16*)(ws + WS_WOUT); C.WmiT = (bf16*)(ws + WS_WMI); C.WmoT = (bf16*)(ws + WS_WMO); C.R1 = (bf16*)(ws + WS_R1); C.proj = (bf16*)(ws + WS_PROJ);
    C.cn = (bf16*)(ws + WS_CN); C.act = (bf16*)(ws + WS_ACT); C.small = (float*)(ws + WS_SMALL); C.mix = (float*)(ws + WS_MIX); C.y = (float*)(ws + WS_Y);
    volatile LAS unsigned* MISC = (volatile LAS unsigned*)(C.lds + MISC_OFF);
    if (C.tid < 16) MISC[C.tid] = 0u;
    __syncthreads();
    const int lo = a.ph_lo, hi = a.ph_hi;
    XcdBarrier bar; bar.bar = (unsigned*)(ws + WS_CTL) + CW_BAR; bar.x = 0; bar.st = nullptr;
    if (hi - lo > 1) bar = xcd_barrier_post((unsigned*)(ws + WS_CTL) + CW_BAR, MISC);
#define IN(k) (lo <= (k) && (k) < hi)
#define SEAM(k) do { if (IN(k) && IN((k) + 1)) xcd_barrier(bar); } while (0)

#ifndef NO_P0
    if (IN(0)) { p0_prologue(C); SEAM(0); }
#endif
#ifndef NO_GEMM
    if (IN(1)) { pg8::Gemm g{C.R1, C.WinT, MROWS, NPROJ, DM}; pg8::StaticOrder S; S.init(MROWS, NPROJ, C.G, (int)blockIdx.x);
        pg8::EpiProj E{C.proj, NPROJ, C.small};
        pg8::gemm_phase<pg8::EpiProj, pg8::StaticOrder, false>(C.lds, g, S, E, nullptr); SEAM(1); }
#endif
#ifndef NO_P2
    if (IN(2)) { p2_cn(C); if (blockIdx.x < 64) p2_gdn_seq(C, blockIdx.x >> 2, blockIdx.x & 3); SEAM(2); }
#endif
#ifndef NO_P3
#ifdef DSA_NAIVE
    if (IN(3)) { p3_dsa(C); SEAM(3); }
#else
    if (IN(3)) { dsa::p3_dsa_mfma(C); SEAM(3); }
#endif
#endif
#ifndef NO_GEMM
    if (IN(4)) { pg8::Gemm g{C.R1, C.WoutT, MROWS, DM, KOUT}; pg8::StaticOrder S; S.init(MROWS, DM, C.G, (int)blockIdx.x);
        pg8::EpiF32 E{C.mix, DM, nullptr};
        pg8::gemm_phase<pg8::EpiF32, pg8::StaticOrder, false>(C.lds, g, S, E, nullptr); SEAM(4); }
#endif
    if (IN(5)) { p5_postnorm(C); SEAM(5); }
#ifndef NO_GEMM
    if (IN(6)) { pg8::Gemm g{C.R1, C.WmiT, MROWS, DFF, DM}; pg8::StaticOrder S; S.init(MROWS, DFF, C.G, (int)blockIdx.x);
        pg8::EpiRelu2 E{C.act, DFF};
        pg8::gemm_phase<pg8::EpiRelu2, pg8::StaticOrder, false>(C.lds, g, S, E, nullptr); SEAM(6); }
    if (IN(7)) { pg8::Gemm g{C.act, C.WmoT, MROWS, DM, DFF}; pg8::StaticOrder S; S.init(MROWS, DM, C.G, (int)blockIdx.x);
        pg8::EpiF32 E{C.y, DM, nullptr};
        pg8::gemm_phase<pg8::EpiF32, pg8::StaticOrder, false>(C.lds, g, S, E, nullptr); SEAM(7); }
#endif
    if (IN(8)) { p8_final(C); }
#undef IN
#undef SEAM
}

extern "C" void kernel_launch(void* const* d_in, const int* in_sizes, int n_in, void* d_out, int out_size, void* d_ws, size_t ws_size, hipStream_t stream) {
    static int grid = 0;
    if (grid == 0) {
        if (n_in != 17 || in_sizes[0] != MROWS * DM || out_size != MROWS * DM || ws_size < WS_END) {
            fprintf(stderr, "kernel_launch: built for 17 inputs, x/out of %d floats, >= %zu bytes of workspace; got n_in %d, in0 %d, out %d, ws %zu; nothing launched\n", MROWS * DM, (size_t)WS_END, n_in, n_in > 0 ? in_sizes[0] : -1, out_size, ws_size); grid = -1; return; }
        int dev = 0, cus = 0, per_cu = 0;
        if (hipGetDevice(&dev) != hipSuccess || hipDeviceGetAttribute(&cus, hipDeviceAttributeMultiprocessorCount, dev) != hipSuccess) { fprintf(stderr, "kernel_launch: device query failed\n"); grid = -1; return; }
        if (hipFuncSetAttribute((const void*)fwd, hipFuncAttributeMaxDynamicSharedMemorySize, LDS_BYTES) != hipSuccess) { fprintf(stderr, "kernel_launch: hipFuncSetAttribute failed\n"); grid = -1; return; }
        if (hipOccupancyMaxActiveBlocksPerMultiprocessor(&per_cu, (const void*)fwd, 512, LDS_BYTES) != hipSuccess || per_cu < 1)
            fprintf(stderr, "kernel_launch: note: occupancy query reports %d workgroups per CU\n", per_cu);
        (void)hipGetLastError();
        grid = cus;
        if (grid < 64) { fprintf(stderr, "kernel_launch: needs >= 64 CUs\n"); grid = -1; return; }
    }
    if (grid < 0) return;
    if (hipMemsetAsync((char*)d_ws + WS_CTL, 0, CTL_ZERO_BYTES, stream) != hipSuccess) { fprintf(stderr, "kernel_launch: memset failed\n"); return; }
    Args a{};
    for (int i = 0; i < 17; ++i) a.in[i] = (const float*)d_in[i];
    a.out = (float*)d_out; a.ws = (unsigned char*)d_ws;
    if (MK_N_LAUNCHES == 1) { a.ph_lo = 0; a.ph_hi = NPHASE; hipLaunchKernelGGL(fwd, dim3(grid), dim3(512), LDS_BYTES, stream, a); }
    else for (int p = 0; p < NPHASE; ++p) { a.ph_lo = p; a.ph_hi = p + 1; hipLaunchKernelGGL(fwd, dim3(grid), dim3(512), LDS_BYTES, stream, a); }
    const hipError_t le = hipPeekAtLastError();
    if (le != hipSuccess) fprintf(stderr, "kernel_launch: launch failed: %s\n", hipGetErrorName(le));
}
```

```cpp
#include <hip/hip_runtime.h>
#include <cstdio>
#include <cstdint>
namespace pg8 {
#define PG8_LAS __attribute__((address_space(3)))
typedef unsigned short bf16_t;
typedef short bf16x8 __attribute__((ext_vector_type(8)));
typedef float f32x4 __attribute__((ext_vector_type(4)));
typedef unsigned u32x4 __attribute__((ext_vector_type(4)));
constexpr int BM = 256, BK = 64, HALF = 128, HTB = HALF * BK * 2  , STAGE_BYTES = 8 * HTB, NXCD = 8, WGM = 8;

__host__ __device__ __forceinline__ int lds_byte(int r, int c) { const int st = (r >> 4) * 2 + (c >> 5), rr = r & 15, cc = c & 31, ob = rr * 64 + cc * 2; return st * 1024 + (ob ^ (((ob >> 9) & 1) << 5)); }
__host__ __device__ __forceinline__ void stage_rc(int b, int& R, int& C) { const int st = b / 1024, sb = b % 1024, swz = sb ^ (((sb >> 9) & 1) << 5); R = (st >> 1) * 16 + swz / 64; C = (st & 1) * 32 + (swz % 64) / 2; }
__host__ __device__ __forceinline__ int perm32(int rho) { const int n = rho >> 4, i = rho & 15; return 8 * (i >> 2) + 4 * n + (i & 3); }

struct Unit { int pm, pn; };
struct Gemm { const bf16_t* A; const bf16_t* Bt; int M, N, K; };

struct StaticOrder {
    int nM, nN, nwg, G, c;
    __host__ __device__ void init(int M, int N, int G_, int c_) { nM = M / BM; nN = N / BM; nwg = nM * nN; G = G_; c = c_; }
    __host__ __device__ bool next(int i, Unit& u) const {
        const long L = (long)i * G + c; if (L >= nwg) return false;
        int wgid = (int)L; { const int q = nwg / NXCD, r = nwg % NXCD, xcd = wgid % NXCD, off = wgid / NXCD; wgid = (xcd < r ? xcd * (q + 1) : r * (q + 1) + (xcd - r) * q) + off; }
        const int nig = WGM * nN, gid = wgid / nig, fm = gid * WGM, gsz = (nM - fm) < WGM ? (nM - fm) : WGM;
        u.pm = fm + ((wgid % nig) % gsz); u.pn = (wgid % nig) / gsz; return true;
    }
    __device__ __forceinline__ void a_ready(const Unit&) const {}
    __device__ __forceinline__ void done(const Unit&) const {}
};
__device__ __forceinline__ unsigned cvt_pk_bf16(float lo, float hi) { unsigned r; asm volatile("v_cvt_pk_bf16_f32 %0, %1, %2" : "=v"(r) : "v"(lo), "v"(hi)); return r; }
typedef float f32x2 __attribute__((ext_vector_type(2)));
struct EpiF32 {
    static constexpr bool PERM = false, AFTER_DRAIN = false;
    float* C; int ldc; const float* bias;
    __device__ __forceinline__ void operator()(const f32x4 (&acc)[2][2][4][2], const Unit& u, int wr, int wc, int fr, int fq) const {
        const int row0 = u.pm * BM + wr * 64 + fr, col0 = u.pn * BM + wc * 32 + 4 * fq;
        f32x4 bv[2][2];
#pragma unroll
        for (int bj = 0; bj < 2; ++bj)
#pragma unroll
            for (int n = 0; n < 2; ++n) bv[bj][n] = bias ? *(const f32x4*)(bias + col0 + bj * HALF + n * 16) : (f32x4){0.f, 0.f, 0.f, 0.f};
#pragma unroll
        for (int ai = 0; ai < 2; ++ai)
#pragma unroll
            for (int m = 0; m < 4; ++m) { float* rowp = C + (size_t)(row0 + ai * HALF + m * 16) * ldc + col0;
#pragma unroll
                for (int bj = 0; bj < 2; ++bj)
#pragma unroll
                    for (int n = 0; n < 2; ++n) *(f32x4*)(rowp + bj * HALF + n * 16) = acc[ai][bj][m][n] + bv[bj][n]; }
    }
};
struct EpiProj {
    static constexpr bool PERM = true, AFTER_DRAIN = false;
    bf16_t* O; int ldc; float* small;
    __device__ __forceinline__ void operator()(const f32x4 (&acc)[2][2][4][2], const Unit& u, int wr, int wc, int fr, int fq) const {
        const int row0 = u.pm * BM + wr * 64 + fr, col0 = u.pn * BM + wc * 32 + 8 * fq;
#pragma unroll
        for (int ai = 0; ai < 2; ++ai)
#pragma unroll
            for (int m = 0; m < 4; ++m) { bf16_t* rowp = O + (size_t)(row0 + ai * HALF + m * 16) * ldc + col0;
#pragma unroll
                for (int bj = 0; bj < 2; ++bj) { const f32x4 v0 = acc[ai][bj][m][0], v1 = acc[ai][bj][m][1];
                    u32x4 w; w.x = cvt_pk_bf16(v0[0], v0[1]); w.y = cvt_pk_bf16(v0[2], v0[3]); w.z = cvt_pk_bf16(v1[0], v1[1]); w.w = cvt_pk_bf16(v1[2], v1[3]);
                    *(u32x4*)(rowp + bj * HALF) = w; } }
        if (u.pn == 4 && wc == 2 && fq < 2) {
#pragma unroll
            for (int ai = 0; ai < 2; ++ai)
#pragma unroll
                for (int m = 0; m < 4; ++m) { float* sp = small + (size_t)(row0 + ai * HALF + m * 16) * 16 + 8 * fq;
                    *(f32x4*)sp = acc[ai][1][m][0]; *(f32x4*)(sp + 4) = acc[ai][1][m][1]; }
        }
    }
};
struct EpiRelu2 {
    static constexpr bool PERM = true, AFTER_DRAIN = false;
    bf16_t* O; int ldc;
    __device__ __forceinline__ void operator()(const f32x4 (&acc)[2][2][4][2], const Unit& u, int wr, int wc, int fr, int fq) const {
        const int row0 = u.pm * BM + wr * 64 + fr, col0 = u.pn * BM + wc * 32 + 8 * fq;
#pragma unroll
        for (int ai = 0; ai < 2; ++ai)
#pragma unroll
            for (int m = 0; m < 4; ++m) { bf16_t* rowp = O + (size_t)(row0 + ai * HALF + m * 16) * ldc + col0;
#pragma unroll
                for (int bj = 0; bj < 2; ++bj) { f32x4 v0 = acc[ai][bj][m][0], v1 = acc[ai][bj][m][1];
#pragma unroll
                    for (int j = 0; j < 4; ++j) { const float a = fmaxf(v0[j], 0.f), b = fmaxf(v1[j], 0.f); v0[j] = a * a; v1[j] = b * b; }
                    u32x4 w; w.x = cvt_pk_bf16(v0[0], v0[1]); w.y = cvt_pk_bf16(v0[2], v0[3]); w.z = cvt_pk_bf16(v1[0], v1[1]); w.w = cvt_pk_bf16(v1[2], v1[3]);
                    *(u32x4*)(rowp + bj * HALF) = w; } }
    }
};
template <class Epi, class Sched, bool STAMP = false>
__device__ __forceinline__ void gemm_phase(PG8_LAS unsigned char* lds, const Gemm g, const Sched& S, const Epi& E, unsigned long long* stamps) {
    const int tid = threadIdx.x, wid = __builtin_amdgcn_readfirstlane(tid >> 6), lane = tid & 63, wr = wid >> 2, wc = wid & 3, fr = lane & 15, fq = lane >> 4;
    const int K = g.K, nt = K / BK;
    int ts_lo = 0, ts_hi = 0, nts = 0; const unsigned long long rt_entry = STAMP ? (unsigned long long)wall_clock64() : 0ull;
#define PG8_STAMP() do { if (STAMP && wid == 0 && nts < 64) { const unsigned long long _c = (unsigned long long)clock64(); \
        ts_lo = (lane == nts) ? (int)(unsigned)_c : ts_lo; ts_hi = (lane == nts) ? (int)(unsigned)(_c >> 32) : ts_hi; ++nts; } } while (0)
    PG8_STAMP();
    unsigned voffA[2], voffB[2];
#pragma unroll
    for (int i = 0; i < 2; ++i) { int R, C; stage_rc(tid * 16 + i * 8192, R, C); const int Rb = Epi::PERM ? ((R & ~31) + perm32(R & 31)) : R;
        voffA[i] = (unsigned)(R * K + C) * 2u; voffB[i] = (unsigned)(Rb * K + C) * 2u; }
    const size_t kstep = (size_t)(BK * 2);
    const size_t hstep = (size_t)HALF * K * 2;
    const size_t tstep = 2 * hstep;
    const unsigned ldsw = (unsigned)wid * 1024u;
    const int aoff = lds_byte(wr * 64 + fr, fq * 8), boff = lds_byte(wc * 32 + fr, fq * 8);
#define PG8_SA(b, h) (((b) * 2 + (h)) * HTB)
#define PG8_SB(b, h) ((4 + (b) * 2 + (h)) * HTB)
#define PG8_STAGE(bufoff, gbase, voff) do { _Pragma("unroll") for (int _i = 0; _i < 2; ++_i) \
        __builtin_amdgcn_global_load_lds((const unsigned*)((const char*)(gbase) + (voff)[_i]), (PG8_LAS unsigned*)(lds + (bufoff) + ldsw + _i * 8192), 16, 0, 0); } while (0)
#define PG8_LDA(dst, b, h) do { _Pragma("unroll") for (int m = 0; m < 4; ++m) _Pragma("unroll") for (int k = 0; k < 2; ++k) dst[m][k] = *(const PG8_LAS bf16x8*)(lds + PG8_SA(b, h) + aoff + m * 2048 + k * 1024); } while (0)
#define PG8_LDB(dst, b, h) do { _Pragma("unroll") for (int n = 0; n < 2; ++n) _Pragma("unroll") for (int k = 0; k < 2; ++k) dst[n][k] = *(const PG8_LAS bf16x8*)(lds + PG8_SB(b, h) + boff + n * 2048 + k * 1024); } while (0)
#define PG8_MMA(ai, bj, At, Bt) do { __builtin_amdgcn_s_setprio(1); _Pragma("unroll") for (int m = 0; m < 4; ++m) _Pragma("unroll") for (int n = 0; n < 2; ++n) _Pragma("unroll") for (int k = 0; k < 2; ++k) \
        acc[ai][bj][m][n] = __builtin_amdgcn_mfma_f32_16x16x32_bf16(Bt[n][k], At[m][k], acc[ai][bj][m][n], 0, 0, 0); __builtin_amdgcn_s_setprio(0); } while (0)
#define PG8_WAIT_V(n) asm volatile("s_waitcnt vmcnt(" #n ")" ::: "memory")
#define PG8_WAIT_L(n) asm volatile("s_waitcnt lgkmcnt(" #n ")" ::: "memory")
#define PG8_BAR __builtin_amdgcn_s_barrier()
#define PG8_SCHED __builtin_amdgcn_sched_barrier(0)
    Unit cur, nxt; int ui = 0;
    if (!S.next(0, cur)) return;
    f32x4 acc[2][2][4][2];
#pragma unroll
    for (int a = 0; a < 2; ++a)
#pragma unroll
        for (int b = 0; b < 2; ++b)
#pragma unroll
            for (int m = 0; m < 4; ++m)
#pragma unroll
                for (int n = 0; n < 2; ++n) acc[a][b][m][n] = (f32x4){0.f, 0.f, 0.f, 0.f};
    bf16x8 At[4][2], B0[2][2], B1[2][2];
    const char* cA = (const char*)g.A + (size_t)cur.pm * tstep; const char* cB = (const char*)g.Bt + (size_t)cur.pn * tstep;
    S.a_ready(cur);
    PG8_STAGE(PG8_SB(0, 0), cB, voffB); PG8_STAGE(PG8_SA(0, 0), cA, voffA); PG8_STAGE(PG8_SB(0, 1), cB + hstep, voffB); PG8_STAGE(PG8_SA(0, 1), cA + hstep, voffA);
    if (wr == 1) PG8_BAR;
    PG8_WAIT_V(4); PG8_BAR;
    PG8_STAGE(PG8_SB(1, 0), cB + kstep, voffB); PG8_STAGE(PG8_SA(1, 0), cA + kstep, voffA); PG8_STAGE(PG8_SB(1, 1), cB + hstep + kstep, voffB);
    PG8_WAIT_V(6); PG8_BAR;
    PG8_STAMP();
    for (;;) {
        const bool has_next = S.next(ui + 1, nxt);
        const char* nA = has_next ? (const char*)g.A + (size_t)nxt.pm * tstep : cA; const char* nB = has_next ? (const char*)g.Bt + (size_t)nxt.pn * tstep : cB;
        for (int t = 0; t < nt; t += 2) {
            const bool last = (t == nt - 2);
            const char* a1 = cA + (size_t)(t + 1) * kstep;
            const char* a2 = last ? nA : cA + (size_t)(t + 2) * kstep; const char* b2 = last ? nB : cB + (size_t)(t + 2) * kstep;
            const char* a3 = a2 + kstep; const char* b3 = b2 + kstep;
            if (last && has_next) S.a_ready(nxt);
            PG8_LDB(B0, 0, 0); PG8_SCHED; PG8_LDA(At, 0, 0); PG8_STAGE(PG8_SA(1, 1), a1 + hstep, voffA);
            PG8_WAIT_L(8); PG8_BAR; PG8_WAIT_L(0); PG8_MMA(0, 0, At, B0); PG8_BAR; PG8_SCHED;
            PG8_LDB(B1, 0, 1); PG8_STAGE(PG8_SB(0, 0), b2, voffB);
            PG8_BAR; PG8_WAIT_L(0); PG8_MMA(0, 1, At, B1); PG8_BAR;
            PG8_LDA(At, 0, 1); PG8_STAGE(PG8_SA(0, 0), a2, voffA);
            PG8_BAR; PG8_WAIT_L(0); PG8_MMA(1, 0, At, B0); PG8_BAR; PG8_SCHED;
            PG8_STAGE(PG8_SB(0, 1), b2 + hstep, voffB);
            PG8_WAIT_V(6); PG8_BAR; PG8_MMA(1, 1, At, B1); PG8_BAR;
            PG8_LDB(B0, 1, 0); PG8_SCHED; PG8_LDA(At, 1, 0); PG8_STAGE(PG8_SA(0, 1), a2 + hstep, voffA);
            PG8_WAIT_L(8); PG8_BAR; PG8_WAIT_L(0); PG8_MMA(0, 0, At, B0); PG8_BAR; PG8_SCHED;
            PG8_LDB(B1, 1, 1); PG8_STAGE(PG8_SB(1, 0), b3, voffB);
            PG8_BAR; PG8_WAIT_L(0); PG8_MMA(0, 1, At, B1); PG8_BAR;
            PG8_LDA(At, 1, 1); PG8_STAGE(PG8_SA(1, 0), a3, voffA);
            PG8_BAR; PG8_WAIT_L(0); PG8_MMA(1, 0, At, B0); PG8_BAR; PG8_SCHED;
            PG8_STAGE(PG8_SB(1, 1), b3 + hstep, voffB);
            PG8_WAIT_V(6); PG8_BAR; PG8_MMA(1, 1, At, B1); PG8_BAR;
        }
        PG8_STAMP();
        if constexpr (!Epi::AFTER_DRAIN) { E(acc, cur, wr, wc, fr, fq); S.done(cur); }
        PG8_STAMP();
        if (!has_next) break;
#pragma unroll
        for (int a = 0; a < 2; ++a)
#pragma unroll
            for (int b = 0; b < 2; ++b)
#pragma unroll
                for (int m = 0; m < 4; ++m)
#pragma unroll
                    for (int n = 0; n < 2; ++n) acc[a][b][m][n] = (f32x4){0.f, 0.f, 0.f, 0.f};
        cur = nxt; cA = nA; cB = nB; ++ui;
    }
    PG8_WAIT_V(0);
    if (wr == 0) PG8_BAR;
    PG8_BAR;
    if constexpr (Epi::AFTER_DRAIN) { E.fused(acc, cur, wr, wc, fr, fq, lds, wid, lane); S.done(cur); }
    PG8_STAMP();
    if (STAMP && wid == 0) { stamps[lane] = lane < nts ? (((unsigned long long)(unsigned)ts_hi << 32) | (unsigned)ts_lo) : 0ull;
        if (lane == 62) stamps[62] = rt_entry; if (lane == 63) stamps[63] = (unsigned long long)wall_clock64(); }
#undef PG8_STAMP
#undef PG8_SA
#undef PG8_SB
#undef PG8_STAGE
#undef PG8_LDA
#undef PG8_LDB
#undef PG8_MMA
#undef PG8_WAIT_V
#undef PG8_WAIT_L
#undef PG8_BAR
#undef PG8_SCHED
}
}
#define XB_TMO      128
#define XB_XCNT(j)  (256  + 64 * (j))
#define XB_XSUB(j)  (1280 + 64 * (j))
#define XB_XGEN(j)  (2304 + 64 * (j))
#define XB_TOP      3328
#define XB_TOPGEN   3392
#define XCD_BAR_WORDS 3456
#define XB_SPIN_CAP (1u << 18)
#define LAS __attribute__((address_space(3)))

__device__ __forceinline__ unsigned xb_ld(unsigned* p)              { return __hip_atomic_load(p, __ATOMIC_RELAXED, __HIP_MEMORY_SCOPE_AGENT); }
__device__ __forceinline__ unsigned xb_add(unsigned* p, unsigned v) { return __hip_atomic_fetch_add(p, v, __ATOMIC_RELAXED, __HIP_MEMORY_SCOPE_AGENT); }
__device__ __forceinline__ unsigned xb_xcc_id() { return (unsigned)__builtin_amdgcn_s_getreg((3 << 11) | 20) & 0xFu; }
#define XB_SPIN(cond, bar) do { unsigned _sp = 0; while (cond) { __builtin_amdgcn_s_sleep(1); \
    if ((++_sp & 255u) == 0u) { if (xb_ld(&(bar)[XB_TMO])) break; if (_sp > XB_SPIN_CAP) { atomicAdd(&(bar)[XB_TMO], 1u); break; } } } } while (0)

struct XcdBarrier {
    unsigned* bar; unsigned x;
    volatile LAS unsigned* st;
};

__device__ __forceinline__ XcdBarrier xcd_barrier_post(unsigned* bar, volatile LAS unsigned* st) {
    XcdBarrier b; b.bar = bar; b.x = xb_xcc_id(); b.st = st;
    if (threadIdx.x == 0) (void)xb_add(&bar[XB_XCNT(b.x)], 1u);
    return b;
}
__device__ __forceinline__ void xcd_barrier_complete(unsigned* bar, unsigned x, unsigned& nloc, unsigned& nx) {
    const unsigned G = gridDim.x * gridDim.y * gridDim.z;
    unsigned sum, cnt, mine, sp = 0u;
    for (;;) {
        sum = 0u; cnt = 0u; mine = 0u;
#pragma unroll
        for (unsigned j = 0; j < 16; ++j) { const unsigned c = xb_ld(&bar[XB_XCNT(j)]); sum += c; cnt += (c > 0u) ? 1u : 0u; mine = (j == x) ? c : mine; }
        if (sum == G) break;
        __builtin_amdgcn_s_sleep(1);
        if ((++sp & 255u) == 0u) { if (xb_ld(&bar[XB_TMO])) break; if (sp > XB_SPIN_CAP) { atomicAdd(&bar[XB_TMO], 1u); break; } }
    }
    nloc = mine > 0u ? mine : 1u; nx = cnt > 0u ? cnt : 1u;
}

__device__ __forceinline__ void xcd_barrier(const XcdBarrier& b) {
    asm volatile("s_waitcnt vmcnt(0)" ::: "memory");
    __syncthreads();
    if (threadIdx.x == 0) {
        unsigned* bar = b.bar;
        __builtin_amdgcn_s_waitcnt(0);
        unsigned nloc = b.st[0], nx = b.st[1];
        if (nloc == 0u) { xcd_barrier_complete(bar, b.x, nloc, nx); b.st[0] = nloc; b.st[1] = nx; }
        const unsigned old = xb_add(&bar[XB_XSUB(b.x)], 1u);
        const unsigned gen = old / nloc;
        if (old + 1u == (gen + 1u) * nloc) {
            __builtin_amdgcn_fence(__ATOMIC_RELEASE, "agent");
            asm volatile("s_waitcnt vmcnt(0)" ::: "memory");
            const unsigned og = xb_add(&bar[XB_TOP], 1u);
            const unsigned tg = og / nx;
            if (og + 1u == (tg + 1u) * nx) xb_add(&bar[XB_TOPGEN], 1u);
            else XB_SPIN(xb_ld(&bar[XB_TOPGEN]) == tg, bar);
            __builtin_amdgcn_fence(__ATOMIC_ACQUIRE, "agent");
            xb_add(&bar[XB_XGEN(b.x)], 1u);
            asm volatile("s_waitcnt vmcnt(0)" ::: "memory");
        } else {
            XB_SPIN(xb_ld(&bar[XB_XGEN(b.x)]) == gen, bar);
            __builtin_amdgcn_fence(__ATOMIC_ACQUIRE, "agent");
            asm volatile("s_waitcnt vmcnt(0)" ::: "memory");
        }
    }
    __syncthreads();
}
#ifndef MK_N_LAUNCHES
#define MK_N_LAUNCHES 1
#endif
constexpr int NPHASE = 10;
constexpr int BATCH = 16, SEQ = 2048, DM = 1024, MROWS = BATCH * SEQ, NPROJ = 3840, DFF = 4096, KOUT = 1536, INC = 3280;
constexpr float EPS = 1e-6f;
constexpr int PC_QABS = 0, PC_CKV = 1024, PC_KIDX = 1152, PC_SMALL = 1216, PC_QIDX = 1280, PC_QB = 1792, PC_KB = 2304, PC_VB = 2816, PC_ZB = 3328;
constexpr size_t MiB = 1u << 20;
constexpr size_t WS_CTL = 0, CTL_ZERO_BYTES = 1 * MiB;
constexpr size_t WS_WMI = 1 * MiB, WS_WMO = 9 * MiB, WS_R1 = 17 * MiB, WS_WOUT = 113 * MiB, WS_WIN = 116 * MiB, WS_SMALL = 124 * MiB, WS_CN = 126 * MiB, WS_PROJ = 134 * MiB;
constexpr size_t WS_MIX = 134 * MiB, WS_ACT = 116 * MiB, WS_Y = 372 * MiB, WS_END = 500 * MiB;
constexpr size_t WS_GU = 374 * MiB, WS_OG = 406 * MiB, WS_ALAST = 470 * MiB;
constexpr int CW_BAR = 4096;
constexpr int LDS_BYTES = 147456, MISC_OFF = LDS_BYTES - 64;

typedef unsigned short bf16;
typedef unsigned v4u __attribute__((ext_vector_type(4)));
typedef float f32x4 __attribute__((ext_vector_type(4)));
typedef float f32x2 __attribute__((ext_vector_type(2)));
#define LDS_WAIT() asm volatile("s_waitcnt lgkmcnt(0)" ::: "memory")
__device__ __forceinline__ unsigned f2bf(float f) { unsigned u = __float_as_uint(f); return (u + 0x7fffu + ((u >> 16) & 1u)) >> 16; }
__device__ __forceinline__ unsigned pk2(float lo, float hi) { return f2bf(lo) | (f2bf(hi) << 16); }
__device__ __forceinline__ float bflo(unsigned u) { return __uint_as_float(u << 16); }
__device__ __forceinline__ float bfhi(unsigned u) { return __uint_as_float(u & 0xffff0000u); }
__device__ __forceinline__ float bf2f(bf16 b) { return __uint_as_float(((unsigned)b) << 16); }
__device__ __forceinline__ float wave_sum(float v) {
#pragma unroll
    for (int o = 1; o < 64; o <<= 1) v += __shfl_xor(v, o);
    return v;
}
__device__ __forceinline__ float wave_max(float v) {
#pragma unroll
    for (int o = 1; o < 64; o <<= 1) v = fmaxf(v, __shfl_xor(v, o));
    return v;
}
__device__ __forceinline__ float silu_f(float x) { return x / (1.0f + __expf(-x)); }
__device__ __forceinline__ float sigmoid_f(float x) { return 1.0f / (1.0f + __expf(-x)); }
__device__ __forceinline__ float softplus_f(float x) { return fmaxf(x, 0.f) + log1pf(__expf(-fabsf(x))); }
__device__ __forceinline__ int t5_bucket(int rel) {
    const int side = rel > 0 ? 16 : 0, n = rel < 0 ? -rel : rel;
    int bk;
    if (n < 8) bk = n; else bk = 8 + (n >= 12) + (n >= 16) + (n >= 23) + (n >= 32) + (n >= 46) + (n >= 64) + (n >= 91);
    return side + bk;
}

struct Args { const float* in[17]; float* out; unsigned char* ws; int ph_lo, ph_hi; };
struct Ctx {
    int tid, lane, wave, G, gw, NGW;
    LAS unsigned char* lds;
    const float *x, *w_in, *c_norm, *w_uk, *w_uv, *rel_bias, *conv_w, *a_log, *dt_bias, *o_norm, *w_out, *g_pre_mix, *g_post_mix, *g_pre_mlp, *g_post_mlp, *w_mi, *w_mo;
    float* out;
    bf16 *WinT, *WoutT, *WmiT, *WmoT, *R1, *proj, *cn, *act;
    float *small, *mix, *y;
    unsigned char *gop, *gU; float *galast, *og;
};

__device__ __forceinline__ void tr_item(const float* W, int ldsrc, int sc0, bf16* WT, int ldd, int dr0, int dc0, float scale, LAS float* scr, int kb, int nb, int lane) {
    const int k0 = 64 * kb, n0 = 32 * nb;
#pragma unroll 8
    for (int i = 0; i < 32; ++i) { const int kk = 2 * i + (lane >> 5); scr[kk * 33 + (lane & 31)] = W[(size_t)(k0 + kk) * ldsrc + sc0 + n0 + (lane & 31)]; }
    LDS_WAIT();
    const int c = lane & 7;
#pragma unroll
    for (int j = 0; j < 4; ++j) { const int n = (lane >> 3) + 8 * j; const LAS float* s = scr + (8 * c) * 33 + n;
        v4u o; o.x = pk2(s[0 * 33] * scale, s[1 * 33] * scale); o.y = pk2(s[2 * 33] * scale, s[3 * 33] * scale); o.z = pk2(s[4 * 33] * scale, s[5 * 33] * scale); o.w = pk2(s[6 * 33] * scale, s[7 * 33] * scale);
        *(v4u*)(WT + (size_t)(dr0 + n0 + n) * ldd + dc0 + k0 + 8 * c) = o; }
    LDS_WAIT();
}
__device__ __forceinline__ void rms_row_to_bf16(const float* xrow, const float* g, bf16* orow, int lane) {
    const f32x4* xr = (const f32x4*)xrow + lane; const f32x4* gr = (const f32x4*)g + lane;
    f32x4 v[4]; float s = 0.f;
#pragma unroll
    for (int j = 0; j < 4; ++j) { v[j] = xr[64 * j]; s += (v[j].x * v[j].x + v[j].y * v[j].y) + (v[j].z * v[j].z + v[j].w * v[j].w); }
    const float rstd = 1.0f / sqrtf(wave_sum(s) * (1.0f / DM) + EPS);
    unsigned long long* o8 = (unsigned long long*)orow + lane;
#pragma unroll
    for (int j = 0; j < 4; ++j) { const f32x4 gg = gr[64 * j];
        o8[64 * j] = (unsigned long long)pk2(v[j].x * rstd * gg.x, v[j].y * rstd * gg.y) | ((unsigned long long)pk2(v[j].z * rstd * gg.z, v[j].w * rstd * gg.w) << 32); }
}
__device__ __forceinline__ void p0_prologue(const Ctx& C) {
    LAS float* scr = (LAS float*)(C.lds + C.wave * 8704);
    const int lane = C.lane;
    for (int it = C.gw; it < 6496; it += C.NGW) {
        int r = it;
        if (r < 64)   { tr_item(C.w_in, INC, 512, C.WinT, DM, PC_CKV, 0, 1.f, scr, r / 4, r % 4, lane); continue; } r -= 64;
        if (r < 32)   { tr_item(C.w_in, INC, 1152, C.WinT, DM, PC_KIDX, 0, 1.f, scr, r / 2, r % 2, lane); continue; } r -= 32;
        if (r < 256)  { tr_item(C.w_in, INC, 640, C.WinT, DM, PC_QIDX, 0, 0.125f, scr, r / 16, r % 16, lane); continue; } r -= 256;
        if (r < 768)  { tr_item(C.w_in, INC, 1224, C.WinT, DM, PC_QB, 0, 1.f, scr, r / 48, r % 48, lane); continue; } r -= 768;
        if (r < 256)  { tr_item(C.w_in, INC, 2768, C.WinT, DM, PC_ZB, 0, 1.f, scr, r / 16, r % 16, lane); continue; } r -= 256;
        if (r < 256)  { tr_item(C.w_out + 512 * 1024, DM, 0, C.WoutT, KOUT, 0, 1024, 1.f, scr, r / 32, r % 32, lane); continue; } r -= 256;
        if (r < 2048) { tr_item(C.w_mi, DFF, 0, C.WmiT, DM, 0, 0, 1.f, scr, r / 128, r % 128, lane); continue; } r -= 2048;
        if (r < 2048) { tr_item(C.w_mo, DM, 0, C.WmoT, DFF, 0, 0, 1.f, scr, r / 32, r % 32, lane); continue; } r -= 2048;
        if (r < 512) {
            const int hh = r / 64, rem = r % 64, kblk = rem / 4, cq = rem % 4, k = kblk * 64 + lane;
            float wr[64]; const f32x4* src = (const f32x4*)(C.w_in + (size_t)k * INC + hh * 64);
#pragma unroll
            for (int i = 0; i < 16; ++i) { const f32x4 v = src[i]; wr[4 * i] = v.x; wr[4 * i + 1] = v.y; wr[4 * i + 2] = v.z; wr[4 * i + 3] = v.w; }
#pragma unroll 1
            for (int c = cq * 32; c < cq * 32 + 32; ++c) { const float* uk = C.w_uk + (size_t)(hh * 128 + c) * 64; float acc = 0.f;
#pragma unroll
                for (int d4 = 0; d4 < 4; ++d4) {
#pragma unroll
                    for (int d = 0; d < 16; ++d) acc += wr[d4 * 16 + d] * uk[d4 * 16 + d];
                    asm volatile("" ::: "memory"); }
                C.WinT[(size_t)(hh * 128 + c) * DM + k] = (bf16)f2bf(acc * 0.125f); }
            continue; } r -= 512;
        {
            const int hh = r / 32, rem = r % 32, cblk = rem / 16, nq = rem % 16, c = cblk * 64 + lane;
            float ur[64]; const f32x4* src = (const f32x4*)(C.w_uv + (size_t)(hh * 128 + c) * 64);
#pragma unroll
            for (int i = 0; i < 16; ++i) { const f32x4 v = src[i]; ur[4 * i] = v.x; ur[4 * i + 1] = v.y; ur[4 * i + 2] = v.z; ur[4 * i + 3] = v.w; }
#pragma unroll 1
            for (int n = nq * 64; n < nq * 64 + 64; ++n) { const float* wo = C.w_out + (size_t)(hh * 64) * DM + n; float acc = 0.f;
#pragma unroll
                for (int d4 = 0; d4 < 4; ++d4) {
#pragma unroll
                    for (int d = 0; d < 16; ++d) acc += ur[d4 * 16 + d] * wo[(size_t)(d4 * 16 + d) * DM];
                    asm volatile("" ::: "memory"); }
                C.WoutT[(size_t)n * KOUT + hh * 128 + c] = (bf16)f2bf(acc); }
        }
    }
    for (int i = blockIdx.x * 512 + C.tid; i < 64 * DM; i += C.G * 512) { const int r = i >> 10, k = i & 1023; float v = 0.f;
        if (r < 8) v = C.w_in[(size_t)k * INC + 1216 + r]; else if (r < 12) v = C.w_in[(size_t)k * INC + 2760 + (r - 8)]; else if (r < 16) v = C.w_in[(size_t)k * INC + 2764 + (r - 12)];
        C.WinT[(size_t)(PC_SMALL + r) * DM + k] = (bf16)f2bf(v); }
    for (int m = C.gw; m < MROWS; m += C.NGW) rms_row_to_bf16(C.x + (size_t)m * DM, C.g_pre_mix, C.R1 + (size_t)m * DM, lane);
}

__device__ __forceinline__ void p2_cn(const Ctx& C) {
    const int lane = C.lane; const float g0 = C.c_norm[2 * lane], g1 = C.c_norm[2 * lane + 1];
    for (int m = C.gw; m < MROWS; m += C.NGW) {
        const unsigned u = *(const unsigned*)(C.proj + (size_t)m * NPROJ + PC_CKV + 2 * lane); const float a = bflo(u), b = bfhi(u);
        const float r = 1.0f / sqrtf(wave_sum(a * a + b * b) * (1.0f / 128.f) + EPS);
        *(unsigned*)(C.cn + (size_t)m * 128 + 2 * lane) = pk2(a * r * g0, b * r * g1); }
}
__device__ __forceinline__ void p2_gdn_seq(const Ctx& C, int b, int h) {
    LAS float* qs = (LAS float*)C.lds; LAS float* ks = qs + 8192; LAS float* vs = ks + 8192; LAS float* ob = vs + 8192; LAS float* gl = ob + 8192; LAS float* bl = gl + 64;
    const int lane = C.lane, wave = C.wave, tid = C.tid;
    float S[128];
#pragma unroll
    for (int i = 0; i < 128; ++i) S[i] = 0.f;
    const float A = __expf(C.a_log[h]), dtb = C.dt_bias[h];
    const float on0 = C.o_norm[2 * lane], on1 = C.o_norm[2 * lane + 1];
    for (int chunk = 0; chunk < 32; ++chunk) {
        const int t0 = chunk * 64;
#pragma unroll 1
        for (int rr = 0; rr < 8; ++rr) { const int r = wave * 8 + rr, t = t0 + r;
#pragma unroll 1
            for (int X = 0; X < 3; ++X) { const int ch = X * 512 + h * 128 + 2 * lane; float a0 = 0.f, a1 = 0.f;
#pragma unroll
                for (int j = 0; j < 4; ++j) { const int tt = t - 3 + j;
                    if (tt >= 0) { const unsigned u = *(const unsigned*)(C.proj + (size_t)(b * SEQ + tt) * NPROJ + PC_QB + ch);
                        a0 += C.conv_w[j * 1536 + ch] * bflo(u); a1 += C.conv_w[j * 1536 + ch + 1] * bfhi(u); } }
                float y0 = silu_f(a0), y1 = silu_f(a1);
                if (X < 2) { const float rn = 1.0f / sqrtf(wave_sum(y0 * y0 + y1 * y1) + EPS); y0 *= rn; y1 *= rn; }
                if (X == 0) { y0 *= 0.08838834764831845f; y1 *= 0.08838834764831845f; }
                LAS float* dst = (X == 0 ? qs : X == 1 ? ks : vs) + r * 128 + 2 * lane; dst[0] = y0; dst[1] = y1; } }
        if (tid < 64) { const size_t m = (size_t)b * SEQ + t0 + tid; const float av = C.small[m * 16 + 8 + h], bv = C.small[m * 16 + 12 + h];
            gl[tid] = -A * softplus_f(av + dtb); bl[tid] = sigmoid_f(bv); }
        __syncthreads();
        if (tid < 128) {
#pragma unroll 1
            for (int t = 0; t < 64; ++t) { const float a = __expf(gl[t]), bt = bl[t]; const LAS float* kr = ks + t * 128; const LAS float* qr = qs + t * 128;
                float kS = 0.f;
#pragma unroll
                for (int d4 = 0; d4 < 8; ++d4) {
#pragma unroll
                    for (int d = 0; d < 16; ++d) kS += kr[d4 * 16 + d] * S[d4 * 16 + d];
                    asm volatile("" ::: "memory"); }
                const float dl = bt * (vs[t * 128 + tid] - a * kS); float o = 0.f;
#pragma unroll
                for (int d4 = 0; d4 < 8; ++d4) {
#pragma unroll
                    for (int d = 0; d < 16; ++d) { const int dd = d4 * 16 + d; S[dd] = a * S[dd] + kr[dd] * dl; o += qr[dd] * S[dd]; }
                    asm volatile("" ::: "memory"); }
                ob[t * 128 + tid] = o; } }
        __syncthreads();
#pragma unroll 1
        for (int rr = 0; rr < 8; ++rr) { const int r = wave * 8 + rr; const size_t m = (size_t)b * SEQ + t0 + r;
            const float o0 = ob[r * 128 + 2 * lane], o1 = ob[r * 128 + 2 * lane + 1];
            const float rstd = 1.0f / sqrtf(wave_sum(o0 * o0 + o1 * o1) * (1.0f / 128.f) + EPS);
            const unsigned zu = *(const unsigned*)(C.proj + m * NPROJ + PC_ZB + h * 128 + 2 * lane);
            *(unsigned*)(C.R1 + m * KOUT + 1024 + h * 128 + 2 * lane) = pk2(o0 * rstd * on0 * silu_f(bflo(zu)), o1 * rstd * on1 * silu_f(bfhi(zu))); }
        __syncthreads();
    }
}

__device__ __forceinline__ unsigned f2key(float f) { unsigned u = __float_as_uint(f); if (u == 0x80000000u) u = 0u; return (u & 0x80000000u) ? ~u : (u | 0x80000000u); }
__device__ __forceinline__ void p3_dsa_query(const Ctx& C, int b, int t, LAS unsigned char* wl) {
    const int lane = C.lane; const size_t m = (size_t)b * SEQ + t; const int N = ((t >> 6) + 1) << 6, ntile = N >> 6, nsel = N < 256 ? N : 256;
    LAS float* qi = (LAS float*)wl; LAS float* qa = qi + 512; LAS int* idx = (LAS int*)(qa + 1024); LAS unsigned* sc = (LAS unsigned*)(idx + 256); LAS float* pp = (LAS float*)sc;
    const bf16* prow = C.proj + m * NPROJ;
#pragma unroll
    for (int i = 0; i < 8; ++i) qi[i * 64 + lane] = bf2f(prow[PC_QIDX + i * 64 + lane]);
#pragma unroll
    for (int i = 0; i < 16; ++i) qa[i * 64 + lane] = bf2f(prow[PC_QABS + i * 64 + lane]);
    float wi[8];
#pragma unroll
    for (int hh = 0; hh < 8; ++hh) wi[hh] = C.small[m * 16 + hh] * 0.35355339059327373f;
    LDS_WAIT();
#pragma unroll 1
    for (int i = 0; i < ntile; ++i) { const int s = i * 64 + lane; const v4u* kr = (const v4u*)(C.proj + (size_t)(b * SEQ + s) * NPROJ + PC_KIDX);
        float kf[64];
#pragma unroll
        for (int j = 0; j < 8; ++j) { const v4u u = kr[j]; kf[8 * j] = bflo(u.x); kf[8 * j + 1] = bfhi(u.x); kf[8 * j + 2] = bflo(u.y); kf[8 * j + 3] = bfhi(u.y); kf[8 * j + 4] = bflo(u.z); kf[8 * j + 5] = bfhi(u.z); kf[8 * j + 6] = bflo(u.w); kf[8 * j + 7] = bfhi(u.w); }
        float score = 0.f;
#pragma unroll
        for (int hh = 0; hh < 8; ++hh) { float d = 0.f;
#pragma unroll
            for (int e = 0; e < 64; ++e) d += qi[hh * 64 + e] * kf[e];
            score += wi[hh] * fmaxf(d, 0.f); asm volatile("" ::: "memory"); }
        sc[s] = f2key(score); }
    LDS_WAIT();
    if (N <= 256) {
        for (int i = 0; i < ntile; ++i) idx[i * 64 + lane] = i * 64 + lane;
    } else {
        unsigned uk[32];
#pragma unroll
        for (int i = 0; i < 32; ++i) uk[i] = (i < ntile) ? sc[i * 64 + lane] : 0u;
        unsigned K = 0u;
#pragma unroll 1
        for (int bit = 31; bit >= 0; --bit) { const unsigned cand = K | (1u << bit); int cnt = 0;
#pragma unroll
            for (int i = 0; i < 32; ++i) if (i < ntile) cnt += __popcll(__ballot(uk[i] >= cand));
            if (cnt >= 256) K = cand; }
        int cgt = 0;
#pragma unroll
        for (int i = 0; i < 32; ++i) if (i < ntile) cgt += __popcll(__ballot(uk[i] > K));
        const int need = 256 - cgt; int base = 0, tie_seen = 0; const unsigned long long lt = (1ull << lane) - 1ull;
#pragma unroll
        for (int i = 0; i < 32; ++i) if (i < ntile) {
            const bool gt = uk[i] > K, eq = uk[i] == K; const unsigned long long mEq = __ballot(eq);
            const int rank_eq = tie_seen + __popcll(mEq & lt); const bool sel = gt || (eq && rank_eq < need);
            const unsigned long long mSel = __ballot(sel); const int pos = base + __popcll(mSel & lt);
            if (sel) idx[pos] = i * 64 + lane;
            base += __popcll(mSel); tie_seen += __popcll(mEq); }
    }
    LDS_WAIT();
#pragma unroll 1
    for (int jj = 0; jj < 4; ++jj) { const int j = jj * 64 + lane;
        if (j < nsel) { const int s = idx[j]; const v4u* cr = (const v4u*)(C.cn + (size_t)(b * SEQ + s) * 128);
            float acc[8];
#pragma unroll
            for (int hh = 0; hh < 8; ++hh) acc[hh] = 0.f;
#pragma unroll 1
            for (int cc = 0; cc < 16; ++cc) { const v4u u = cr[cc]; float cv[8]; cv[0] = bflo(u.x); cv[1] = bfhi(u.x); cv[2] = bflo(u.y); cv[3] = bfhi(u.y); cv[4] = bflo(u.z); cv[5] = bfhi(u.z); cv[6] = bflo(u.w); cv[7] = bfhi(u.w);
#pragma unroll
                for (int hh = 0; hh < 8; ++hh)
#pragma unroll
                    for (int e = 0; e < 8; ++e) acc[hh] += qa[hh * 128 + cc * 8 + e] * cv[e]; }
            const int bk = t5_bucket(s - t);
#pragma unroll
            for (int hh = 0; hh < 8; ++hh) pp[j * 8 + hh] = acc[hh] + C.rel_bias[bk * 8 + hh];
        } else {
#pragma unroll
            for (int hh = 0; hh < 8; ++hh) pp[j * 8 + hh] = -__builtin_inff();
        } }
    LDS_WAIT();
#pragma unroll
    for (int hh = 0; hh < 8; ++hh) { float v[4]; float mx = -__builtin_inff();
#pragma unroll
        for (int jj = 0; jj < 4; ++jj) { v[jj] = pp[(jj * 64 + lane) * 8 + hh]; mx = fmaxf(mx, v[jj]); }
        mx = wave_max(mx); float sm = 0.f;
#pragma unroll
        for (int jj = 0; jj < 4; ++jj) { v[jj] = __expf(v[jj] - mx); sm += v[jj]; }
        sm = 1.0f / wave_sum(sm);
#pragma unroll
        for (int jj = 0; jj < 4; ++jj) pp[(jj * 64 + lane) * 8 + hh] = v[jj] * sm; }
    LDS_WAIT();
    float o0[8], o1[8];
#pragma unroll
    for (int hh = 0; hh < 8; ++hh) { o0[hh] = 0.f; o1[hh] = 0.f; }
#pragma unroll 2
    for (int j = 0; j < nsel; ++j) { const int s = idx[j]; const unsigned u = *(const unsigned*)(C.cn + (size_t)(b * SEQ + s) * 128 + 2 * lane); const float c0 = bflo(u), c1 = bfhi(u);
        const f32x4 pa = *(const LAS f32x4*)(pp + j * 8), pb = *(const LAS f32x4*)(pp + j * 8 + 4);
        o0[0] += pa.x * c0; o1[0] += pa.x * c1; o0[1] += pa.y * c0; o1[1] += pa.y * c1; o0[2] += pa.z * c0; o1[2] += pa.z * c1; o0[3] += pa.w * c0; o1[3] += pa.w * c1;
        o0[4] += pb.x * c0; o1[4] += pb.x * c1; o0[5] += pb.y * c0; o1[5] += pb.y * c1; o0[6] += pb.z * c0; o1[6] += pb.z * c1; o0[7] += pb.w * c0; o1[7] += pb.w * c1; }
#pragma unroll
    for (int hh = 0; hh < 8; ++hh) *(unsigned*)(C.R1 + m * KOUT + hh * 128 + 2 * lane) = pk2(o0[hh], o1[hh]);
    LDS_WAIT();
}
__device__ __forceinline__ void p3_dsa(const Ctx& C) {
    LAS unsigned char* wl = C.lds + C.wave * 15360;
    for (int q = C.gw; q < MROWS; q += C.NGW) { const int b = q >> 11, t = ((q & 2047) + 128 * b) & 2047; p3_dsa_query(C, b, t, wl); }
}

__device__ __forceinline__ void p5_postnorm(const Ctx& C) {
    const int lane = C.lane;
    for (int m = C.gw; m < MROWS; m += C.NGW) {
        const f32x4* mr = (const f32x4*)(C.mix + (size_t)m * DM) + lane; const f32x4* xr = (const f32x4*)(C.x + (size_t)m * DM) + lane; f32x4* orow = (f32x4*)(C.out + (size_t)m * DM) + lane;
        const f32x4* g1 = (const f32x4*)C.g_post_mix + lane; const f32x4* g2 = (const f32x4*)C.g_pre_mlp + lane;
        f32x4 v[4]; float s = 0.f;
#pragma unroll
        for (int j = 0; j < 4; ++j) { v[j] = mr[64 * j]; s += (v[j].x * v[j].x + v[j].y * v[j].y) + (v[j].z * v[j].z + v[j].w * v[j].w); }
        const float rstd = 1.0f / sqrtf(wave_sum(s) * (1.0f / DM) + EPS); float s2 = 0.f;
#pragma unroll
        for (int j = 0; j < 4; ++j) { v[j] = xr[64 * j] + v[j] * rstd * g1[64 * j]; orow[64 * j] = v[j]; s2 += (v[j].x * v[j].x + v[j].y * v[j].y) + (v[j].z * v[j].z + v[j].w * v[j].w); }
        const float rstd2 = 1.0f / sqrtf(wave_sum(s2) * (1.0f / DM) + EPS);
        unsigned long long* o8 = (unsigned long long*)(C.R1 + (size_t)m * DM) + lane;
#pragma unroll
        for (int j = 0; j < 4; ++j) { const f32x4 gg = g2[64 * j];
            o8[64 * j] = (unsigned long long)pk2(v[j].x * rstd2 * gg.x, v[j].y * rstd2 * gg.y) | ((unsigned long long)pk2(v[j].z * rstd2 * gg.z, v[j].w * rstd2 * gg.w) << 32); }
    }
}
__device__ __forceinline__ void p8_final(const Ctx& C) {
    const int lane = C.lane;
    for (int m = C.gw; m < MROWS; m += C.NGW) {
        const f32x4* yr = (const f32x4*)(C.y + (size_t)m * DM) + lane; f32x4* orow = (f32x4*)(C.out + (size_t)m * DM) + lane; const f32x4* g1 = (const f32x4*)C.g_post_mlp + lane;
        f32x4 v[4]; float s = 0.f;
#pragma unroll
        for (int j = 0; j < 4; ++j) { v[j] = yr[64 * j]; s += (v[j].x * v[j].x + v[j].y * v[j].y) + (v[j].z * v[j].z + v[j].w * v[j].w); }
        const float rstd = 1.0f / sqrtf(wave_sum(s) * (1.0f / DM) + EPS);
#pragma unroll
        for (int j = 0; j < 4; ++j) orow[64 * j] = orow[64 * j] + v[j] * rstd * g1[64 * j];
    }
}

namespace dsa {
using bf16x8 = __attribute__((ext_vector_type(8))) short;
using s16x4  = __attribute__((ext_vector_type(4))) short;
using f32x16 = __attribute__((ext_vector_type(16))) float;
using f32x4v = __attribute__((ext_vector_type(4))) float;
using u32x4  = __attribute__((ext_vector_type(4))) unsigned;
typedef unsigned long long u64;
constexpr int KVB = 16384;
constexpr int OFF_V = 0, OFF_K = 2 * KVB, OFF_WS = 4 * KVB, OFF_BIAS = OFF_WS + 8 * 256, BIAS_N = 288, BIAS_Z = 224, OFF_MASK = 132096;
constexpr float THR = 8.f;
#define KSWZ(row, colB) ((row) * 256 + ((colB) ^ (((row) & 7) << 4)))
#define SBAR() __builtin_amdgcn_sched_barrier(0)
__device__ __forceinline__ int crow(int r, int hi) { return (r & 3) + 8 * (r >> 2) + 4 * hi; }
__device__ __forceinline__ unsigned cvtpk(float lo, float hi) { unsigned r; asm volatile("v_cvt_pk_bf16_f32 %0, %1, %2" : "=v"(r) : "v"(lo), "v"(hi)); return r; }
__device__ __forceinline__ float maskf(float p, unsigned w, int c) { const int m = ((int)(w << (31 - c))) >> 31; return __uint_as_float(__float_as_uint(p) & (unsigned)m); }

__device__ __forceinline__ void partialSM(f32x16& p0, f32x16& p1, float& m_reg, float& mn, float& alpha, float badd, unsigned mlo) {
  constexpr float C = 1.4426950408889634f;
  float pmax = p0[0];
#pragma unroll
  for (int r = 1; r < 16; ++r) pmax = fmaxf(pmax, p0[r]);
#pragma unroll
  for (int r = 0; r < 16; ++r) pmax = fmaxf(pmax, p1[r]);
  { auto rr = __builtin_amdgcn_permlane32_swap(__float_as_uint(pmax), __float_as_uint(pmax), false, false);
    pmax = fmaxf(__uint_as_float(rr[0]), __uint_as_float(rr[1])); }
  pmax += badd;
  if (__builtin_expect(__all(pmax - m_reg <= THR), 1)) { mn = m_reg; alpha = 1.f; }
  else { mn = fmaxf(m_reg, pmax); alpha = __builtin_amdgcn_exp2f((m_reg - mn) * C); m_reg = mn; }
  const float mnC = (badd - mn) * C;
#pragma unroll
  for (int r = 0; r < 16; ++r) p0[r] = fmaf(p0[r], C, mnC);
#pragma unroll
  for (int r = 0; r < 16; ++r) p1[r] = fmaf(p1[r], C, mnC);
#pragma unroll
  for (int r = 0; r < 16; ++r) p0[r] = maskf(__builtin_amdgcn_exp2f(p0[r]), mlo, (r & 3) + 8 * (r >> 2));
}
__device__ __forceinline__ void finishSM(f32x16& p0, f32x16& p1, float alpha, float& l_reg, bf16x8& pa0, bf16x8& pa1, bf16x8& pa2, bf16x8& pa3, unsigned mhi) {
#pragma unroll
  for (int r = 0; r < 16; ++r) p1[r] = maskf(__builtin_amdgcn_exp2f(p1[r]), mhi, (r & 3) + 8 * (r >> 2));
  float ps = 0;
#pragma unroll
  for (int r = 0; r < 16; ++r) ps += p0[r];
#pragma unroll
  for (int r = 0; r < 16; ++r) ps += p1[r];
  { auto rr = __builtin_amdgcn_permlane32_swap(__float_as_uint(ps), __float_as_uint(ps), false, false);
    ps = __uint_as_float(rr[0]) + __uint_as_float(rr[1]); }
  l_reg = l_reg * alpha + ps;
#define PK4(P, BASE, OUT) do { unsigned a0 = cvtpk(P[BASE + 0], P[BASE + 1]), a1 = cvtpk(P[BASE + 2], P[BASE + 3]);   \
    unsigned b0 = cvtpk(P[BASE + 4], P[BASE + 5]), b1 = cvtpk(P[BASE + 6], P[BASE + 7]);                              \
    auto r0 = __builtin_amdgcn_permlane32_swap(a0, b0, false, false); auto r1 = __builtin_amdgcn_permlane32_swap(a1, b1, false, false); \
    u32x4 w = {r0[0], r1[0], r0[1], r1[1]}; OUT = *reinterpret_cast<bf16x8*>(&w); } while (0)
  PK4(p0, 0, pa0); PK4(p0, 8, pa1); PK4(p1, 0, pa2); PK4(p1, 8, pa3);
#undef PK4
}
__device__ __forceinline__ void qkt(f32x16& p0, f32x16& p1, const LAS char* Ks, const bf16x8* qr, int r32, int hi) {
  p0 = f32x16{}; p1 = f32x16{};
#pragma unroll
  for (int d0 = 0; d0 < 8; ++d0) { const int cb = (d0 * 16 + hi * 8) * 2;
    const bf16x8 b0 = *reinterpret_cast<const LAS bf16x8*>(Ks + KSWZ(r32, cb));
    const bf16x8 b1 = *reinterpret_cast<const LAS bf16x8*>(Ks + KSWZ(32 + r32, cb));
    p0 = __builtin_amdgcn_mfma_f32_32x32x16_bf16(b0, qr[d0], p0, 0, 0, 0);
    p1 = __builtin_amdgcn_mfma_f32_32x32x16_bf16(b1, qr[d0], p1, 0, 0, 0); }
}
__device__ __forceinline__ int v_st(int k, int c) { const int kk = (k & ~0xC) | ((k & 4) << 1) | ((k & 8) >> 1); return ((kk >> 3) * 4 + (c >> 5)) * 512 + ((kk & 7) * 32 + (c & 31)) * 2; }
__device__ __forceinline__ int v_rd_base(int lane) { return ((lane & 3) << 3) | (((lane >> 2) & 3) << 6) | (((lane >> 4) & 1) << 5) | (((lane >> 5) & 1) << 8); }
constexpr int v_rd_off(int d0, int ks, int half) { return d0 * 512 + ks * 4096 + half * 2048; }
template <int OFF> __device__ __forceinline__ s16x4 tr_read(int vb) {
  s16x4 r; asm volatile("ds_read_b64_tr_b16 %0, %1 offset:%2" : "=&v"(r) : "v"(vb), "i"(OFF) : "memory"); return r;
}
template <int D0> __device__ __forceinline__ void pv_one(f32x16& od, int vb, bf16x8 pa0, bf16x8 pa1, bf16x8 pa2, bf16x8 pa3) {
  const s16x4 l0 = tr_read<v_rd_off(D0, 0, 0)>(vb), h0 = tr_read<v_rd_off(D0, 0, 1)>(vb), l1 = tr_read<v_rd_off(D0, 1, 0)>(vb), h1 = tr_read<v_rd_off(D0, 1, 1)>(vb);
  const s16x4 l2 = tr_read<v_rd_off(D0, 2, 0)>(vb), h2 = tr_read<v_rd_off(D0, 2, 1)>(vb), l3 = tr_read<v_rd_off(D0, 3, 0)>(vb), h3 = tr_read<v_rd_off(D0, 3, 1)>(vb);
  asm volatile("s_waitcnt lgkmcnt(0)" ::: "memory"); SBAR();
#define PK(L, H) (bf16x8){L[0], L[1], L[2], L[3], H[0], H[1], H[2], H[3]}
  od = __builtin_amdgcn_mfma_f32_32x32x16_bf16(pa0, PK(l0, h0), od, 0, 0, 0);
  od = __builtin_amdgcn_mfma_f32_32x32x16_bf16(pa1, PK(l1, h1), od, 0, 0, 0);
  od = __builtin_amdgcn_mfma_f32_32x32x16_bf16(pa2, PK(l2, h2), od, 0, 0, 0);
  od = __builtin_amdgcn_mfma_f32_32x32x16_bf16(pa3, PK(l3, h3), od, 0, 0, 0);
#undef PK
}
__device__ __forceinline__ void pv_d0(f32x16* o, int vb, bf16x8 pa0, bf16x8 pa1, bf16x8 pa2, bf16x8 pa3) {
  pv_one<0>(o[0], vb, pa0, pa1, pa2, pa3); pv_one<1>(o[1], vb, pa0, pa1, pa2, pa3); pv_one<2>(o[2], vb, pa0, pa1, pa2, pa3); pv_one<3>(o[3], vb, pa0, pa1, pa2, pa3);
}

__device__ __forceinline__ void attn_item(const Ctx& C, int b, int q0, int N) {
  const int tid = C.tid, wid = C.wave, lane = C.lane, r32 = lane & 31, hi = lane >> 5;
  const int NT = N >> 6;
  LAS char* V_lds = (LAS char*)C.lds + OFF_V; LAS char* K_lds = (LAS char*)C.lds + OFF_K;
  LAS float* wsp = (LAS float*)(C.lds + OFF_WS) + wid * 64; LAS float* li_l = wsp; LAS float* al_l = wsp + 32;
  const LAS float* btab = (const LAS float*)(C.lds + OFF_BIAS) + wid * BIAS_N;
  const LAS u64* mrow = (const LAS u64*)(C.lds + OFF_MASK) + r32 * 32;
  const float b15 = C.rel_bias[15 * 8 + wid];
  float m_reg = -1e30f, l_reg = 0.f; f32x16 o[4] = {}; bf16x8 qr[8];
  const bf16* Qw = C.proj + (size_t)(b * SEQ + q0 + r32) * NPROJ + PC_QABS + wid * 128 + hi * 8;
#pragma unroll
  for (int d0 = 0; d0 < 8; ++d0) qr[d0] = *reinterpret_cast<const bf16x8*>(Qw + d0 * 16);
  const int sr = tid >> 4, sc = (tid & 15) * 8, vst0 = v_st(sr, sc), vst1 = v_st(32 + sr, sc), kst0 = KSWZ(sr, sc * 2), kst1 = KSWZ(32 + sr, sc * 2);
  const int vb0 = (int)(unsigned)(size_t)V_lds + v_rd_base(lane);
  const bf16* Cb = C.cn + (size_t)b * SEQ * 128 + sc;
  bf16x8 sA0, sA1;
#define SLOAD(S0, S1, k0) do { S0 = *reinterpret_cast<const bf16x8*>(Cb + (size_t)((k0) + sr) * 128); S1 = *reinterpret_cast<const bf16x8*>(Cb + (size_t)((k0) + 32 + sr) * 128); } while (0)
#define SWRITE(bf, S0, S1) do { *reinterpret_cast<LAS bf16x8*>(V_lds + (bf) * KVB + vst0) = S0; *reinterpret_cast<LAS bf16x8*>(V_lds + (bf) * KVB + vst1) = S1; \
    *reinterpret_cast<LAS bf16x8*>(K_lds + (bf) * KVB + kst0) = S0; *reinterpret_cast<LAS bf16x8*>(K_lds + (bf) * KVB + kst1) = S1; } while (0)
#define SWAIT() asm volatile("s_waitcnt vmcnt(2)" ::: "memory")
#define RESC(a) do { if (__any((a) < 1.f)) { if (hi == 0) al_l[r32] = (a); asm volatile("s_waitcnt lgkmcnt(0)" ::: "memory"); \
    _Pragma("unroll") for (int d = 0; d < 4; ++d) _Pragma("unroll") for (int r = 0; r < 16; ++r) o[d][r] *= al_l[crow(r, hi)]; } } while (0)
#define SCORE(P0, P1, bf, jt, BADD, MW) do { qkt(P0, P1, K_lds + (bf) * KVB, qr, r32, hi); MW = mrow[(jt)]; \
    if ((jt) < NT && 64 * (jt) + 63 - q0 > -128) { const LAS float* tb = btab + (64 * (jt) - q0 - r32 + BIAS_Z + 4 * hi); BADD = 0.f; \
      _Pragma("unroll") for (int r = 0; r < 16; ++r) { const int c = (r & 3) + 8 * (r >> 2); P0[r] += tb[c]; P1[r] += tb[32 + c]; } } \
    else BADD = b15; } while (0)
#define MLO(MW) (((unsigned)(MW)) >> (4 * hi))
#define MHI(MW) (((unsigned)((MW) >> 32)) >> (4 * hi))
  f32x16 pA0, pA1; float mnA, alA, bdA; u64 mwA; bf16x8 pa0, pa1, pa2, pa3;
  SLOAD(sA0, sA1, 0); asm volatile("s_waitcnt vmcnt(0)" ::: "memory"); SWRITE(0, sA0, sA1); __syncthreads();
  if (1 < NT) SLOAD(sA0, sA1, 64);
#pragma unroll 1
  for (int jt = 0; jt < NT; ++jt) { const int cur = jt & 1;
    SBAR(); SCORE(pA0, pA1, cur, jt, bdA, mwA);
    partialSM(pA0, pA1, m_reg, mnA, alA, bdA, MLO(mwA));
    RESC(alA);
    finishSM(pA0, pA1, alA, l_reg, pa0, pa1, pa2, pa3, MHI(mwA)); SBAR();
    pv_d0(o, vb0 + cur * KVB, pa0, pa1, pa2, pa3);
    if (jt + 1 < NT) { SWRITE(cur ^ 1, sA0, sA1); if (jt + 2 < NT) SLOAD(sA0, sA1, (jt + 2) * 64); }
    __syncthreads();
  }
  if (hi == 0) li_l[r32] = l_reg; asm volatile("s_waitcnt lgkmcnt(0)" ::: "memory");
  float rli[16];
#pragma unroll
  for (int r = 0; r < 16; ++r) rli[r] = __builtin_amdgcn_rcpf(li_l[crow(r, hi)]);
  bf16* Ow = C.R1 + (size_t)(b * SEQ + q0) * KOUT + wid * 128;
#pragma unroll
  for (int r = 0; r < 16; ++r) { const int orow = crow(r, hi);
#pragma unroll
    for (int d0 = 0; d0 < 4; ++d0) Ow[(size_t)orow * KOUT + d0 * 32 + r32] = (bf16)f2bf(o[d0][r] * rli[r]); }
#undef SLOAD
#undef SWRITE
#undef SWAIT
#undef RESC
#undef SCORE
#undef MLO
#undef MHI
}

__device__ __forceinline__ void scores16(const Ctx& C, int b, int q0g, int N) {
  const int lane = C.lane, lq = lane & 15, g = lane >> 4, wave = C.wave;
  LAS float* sc = (LAS float*)C.lds;
  const bf16* prow = C.proj + (size_t)(b * SEQ + q0g + lq) * NPROJ + PC_QIDX + g * 8;
  bf16x8 bq[8][2]; float wv[8];
#pragma unroll
  for (int hh = 0; hh < 8; ++hh) { bq[hh][0] = *reinterpret_cast<const bf16x8*>(prow + hh * 64); bq[hh][1] = *reinterpret_cast<const bf16x8*>(prow + hh * 64 + 32);
    wv[hh] = C.small[(size_t)(b * SEQ + q0g + lq) * 16 + hh] * 0.35355339059327373f; }
  const int nt16 = N >> 4;
  const bf16* kbase = C.proj + (size_t)(b * SEQ + lq) * NPROJ + PC_KIDX + g * 8;
  bf16x8 a0, a1, n0, n1;
  if (wave < nt16) { const bf16* kr = kbase + (size_t)(16 * wave) * NPROJ; n0 = *reinterpret_cast<const bf16x8*>(kr); n1 = *reinterpret_cast<const bf16x8*>(kr + 32); }
  for (int j = wave; j < nt16; j += 8) {
    a0 = n0; a1 = n1;
    if (j + 8 < nt16) { const bf16* kr = kbase + (size_t)(16 * (j + 8)) * NPROJ; n0 = *reinterpret_cast<const bf16x8*>(kr); n1 = *reinterpret_cast<const bf16x8*>(kr + 32); }
    f32x4v acc[8];
#pragma unroll
    for (int hh = 0; hh < 8; ++hh) acc[hh] = __builtin_amdgcn_mfma_f32_16x16x32_bf16(a0, bq[hh][0], (f32x4v){0.f, 0.f, 0.f, 0.f}, 0, 0, 0);
#pragma unroll
    for (int hh = 0; hh < 8; ++hh) acc[hh] = __builtin_amdgcn_mfma_f32_16x16x32_bf16(a1, bq[hh][1], acc[hh], 0, 0, 0);
    f32x4v s4 = {0.f, 0.f, 0.f, 0.f};
#pragma unroll
    for (int hh = 0; hh < 8; ++hh)
#pragma unroll
      for (int r = 0; r < 4; ++r) s4[r] += wv[hh] * fmaxf(acc[hh][r], 0.f);
    *reinterpret_cast<LAS f32x4v*>(sc + lq * (N + 4) + 16 * j + 4 * g) = s4;
  }
}
__device__ __forceinline__ void select16(const Ctx& C, int grp, int N) {
  const int lane = C.lane, NT = N >> 6;
  const LAS float* sc = (const LAS float*)C.lds; LAS u64* mask = (LAS u64*)(C.lds + OFF_MASK);
#pragma unroll 1
  for (int qq = 2 * C.wave; qq < 2 * C.wave + 2; ++qq) {
    const LAS float* row = sc + qq * (N + 4);
    unsigned uk[32];
#pragma unroll
    for (int i = 0; i < 32; ++i) uk[i] = (i < NT) ? f2key(row[i * 64 + lane]) : 0u;
    unsigned K = 0u; bool exact = false;
#pragma unroll 1
    for (int bit = 31; bit >= 0; --bit) { const unsigned cand = K | (1u << bit); int cnt = 0;
#pragma unroll
      for (int i = 0; i < 32; ++i) if (i < NT) cnt += __popcll(__ballot(uk[i] >= cand));
      if (cnt >= 256) { K = cand; if (cnt == 256) { exact = true; break; } } }
    LAS u64* mq = mask + (grp * 16 + qq) * 32;
    if (exact) {
#pragma unroll
      for (int i = 0; i < 32; ++i) if (i < NT) { const u64 m = __ballot(uk[i] >= K); if (lane == 0) mq[i] = m; }
    } else {
      int cgt = 0;
#pragma unroll
      for (int i = 0; i < 32; ++i) if (i < NT) cgt += __popcll(__ballot(uk[i] > K));
      const int need = 256 - cgt; int tie_seen = 0; const u64 lt = (1ull << lane) - 1ull;
#pragma unroll
      for (int i = 0; i < 32; ++i) if (i < NT) {
        const bool gt = uk[i] > K, eq = uk[i] == K; const u64 mEq = __ballot(eq);
        const int rank_eq = tie_seen + __popcll(mEq & lt); const bool sel = gt || (eq && rank_eq < need);
        const u64 m = __ballot(sel); if (lane == 0) mq[i] = m;
        tie_seen += __popcll(mEq); }
    }
    if (lane == 0 && NT < 32) mq[NT] = 0ull;
  }
}
__device__ __forceinline__ void dsa_item(const Ctx& C, int b, int qb) {
  const int q0 = qb * 32, N = ((qb >> 1) + 1) * 64, NT = N >> 6, tid = C.tid;
  LAS u64* mask = (LAS u64*)(C.lds + OFF_MASK);
  if (N <= 256) {
    for (int i = tid; i < 32 * 32; i += 512) mask[i] = ((i & 31) < NT) ? ~0ull : 0ull;
  } else {
#pragma unroll 1
    for (int grp = 0; grp < 2; ++grp) { scores16(C, b, q0 + 16 * grp, N); __syncthreads(); select16(C, grp, N); __syncthreads(); }
  }
  { LAS float* bt = (LAS float*)(C.lds + OFF_BIAS);
    for (int i = tid; i < 8 * BIAS_N; i += 512) { const int hh = i / BIAS_N, e = i % BIAS_N; bt[i] = C.rel_bias[t5_bucket(e - BIAS_Z) * 8 + hh]; } }
  __syncthreads();
  attn_item(C, b, q0, N);
  __syncthreads();
}
__device__ __forceinline__ void p3_dsa_mfma(const Ctx& C) {
  for (int pi = blockIdx.x; pi < 512; pi += C.G) { const int b = pi >> 5, pr = pi & 31;
    dsa_item(C, b, 63 - pr); dsa_item(C, b, pr); }
}
#undef KSWZ
#undef SBAR
}
namespace gdn {
using bf16x8 = __attribute__((ext_vector_type(8))) short;
using f32x16 = __attribute__((ext_vector_type(16))) float;
using f32x4v = __attribute__((ext_vector_type(4))) float;
using u32x4  = __attribute__((ext_vector_type(4))) unsigned;
using u32x2  = __attribute__((ext_vector_type(2))) unsigned;
typedef __bf16 bf2 __attribute__((ext_vector_type(2)));
typedef float fl2 __attribute__((ext_vector_type(2)));
__device__ __forceinline__ unsigned pkbf(float lo, float hi) { fl2 v = {lo, hi}; return __builtin_bit_cast(unsigned, __builtin_convertvector(v, bf2)); }
__device__ __forceinline__ int crow(int r, int hi) { return (r & 3) + 8 * (r >> 2) + 4 * hi; }
constexpr int LDF = 132, LDB = 136, LDL = 68;
constexpr int OFF_KF = 0, OFF_VF = 33792, OFF_KB = 67584, OFF_QB = 84992, OFF_LM = 102400, OFF_IN = 119808, OFF_GT = 137216;
constexpr size_t OPB = 57344, OP_W = 0, OP_QG = 16384, OP_KG = 32768, OP_IN = 49152, UB = 16384;

#define FNMA(acc, a, b) asm("v_fma_f32 %0, -%1, %2, %0" : "+v"(acc) : "v"(a), "v"(b))
__device__ __forceinline__ void g1_item(const Ctx& C, int item) {
  const int b = item >> 7, h = (item >> 5) & 3, c = item & 31, tid = C.tid, lane = C.lane, wave = C.wave, t0 = c * 64;
  unsigned lb0 = (unsigned)(size_t)C.lds, lb1 = (unsigned)(size_t)C.lds + OFF_LM;
  asm volatile("" : "+v"(lb0)); asm volatile("" : "+v"(lb1));
  LAS float* KF = (LAS float*)(size_t)(lb0 + OFF_KF); LAS float* VF = (LAS float*)(size_t)(lb0 + OFF_VF);
  LAS unsigned short* KB = (LAS unsigned short*)(size_t)(lb1 + (OFF_KB - OFF_LM)); LAS unsigned short* QB = (LAS unsigned short*)(size_t)(lb1 + (OFF_QB - OFF_LM));
  LAS float* LM = (LAS float*)(size_t)(lb1); LAS float* IN = (LAS float*)(size_t)(lb1 + (OFF_IN - OFF_LM));
  LAS float* gc = (LAS float*)(size_t)(lb1 + (OFF_GT - OFF_LM)); LAS float* be = gc + 64; LAS float* eg = be + 64; LAS float* ekl = eg + 64;
  unsigned char* gop = C.gop + (size_t)item * OPB; unsigned char* gu = C.gU + (size_t)item * UB;
  if (wave == 0) { const size_t m = (size_t)b * SEQ + t0 + lane; const float av = C.small[m * 16 + 8 + h], bv = C.small[m * 16 + 12 + h];
    float g = -__expf(C.a_log[h]) * softplus_f(av + C.dt_bias[h]);
#pragma unroll
    for (int o = 1; o < 64; o <<= 1) { const float t = __shfl_up(g, o); if (lane >= o) g += t; }
    const float gl = __shfl(g, 63);
    gc[lane] = g; be[lane] = sigmoid_f(bv); eg[lane] = __expf(g); ekl[lane] = __expf(gl - g);
    if (lane == 63) C.galast[item] = __expf(g); }
#pragma unroll 1
  for (int rr = 0; rr < 8; ++rr) { const int r = wave * 8 + rr, t = t0 + r;
#pragma unroll 1
    for (int X = 0; X < 3; ++X) { const int ch = X * 512 + h * 128 + 2 * lane; float a0 = 0.f, a1 = 0.f;
#pragma unroll
      for (int j = 0; j < 4; ++j) { const int tt = t - 3 + j;
        if (tt >= 0) { const unsigned u = *(const unsigned*)(C.proj + (size_t)(b * SEQ + tt) * NPROJ + PC_QB + ch);
          a0 += C.conv_w[j * 1536 + ch] * bflo(u); a1 += C.conv_w[j * 1536 + ch + 1] * bfhi(u); } }
      float y0 = silu_f(a0), y1 = silu_f(a1);
      if (X < 2) { const float rn = 1.0f / sqrtf(wave_sum(y0 * y0 + y1 * y1) + EPS); y0 *= rn; y1 *= rn; }
      if (X == 0) { *(LAS unsigned*)(QB + r * LDB + 2 * lane) = pkbf(y0 * 0.08838834764831845f, y1 * 0.08838834764831845f); }
      else if (X == 1) { KF[r * LDF + 2 * lane] = y0; KF[r * LDF + 2 * lane + 1] = y1; *(LAS unsigned*)(KB + r * LDB + 2 * lane) = pkbf(y0, y1); }
      else { VF[r * LDF + 2 * lane] = y0; VF[r * LDF + 2 * lane + 1] = y1; } } }
  __syncthreads();
  { const int p = wave >> 2, tr = wave & 3, lr = lane & 15, g4 = lane >> 4; const LAS unsigned short* As = p ? QB : KB;
    bf16x8 af[4];
#pragma unroll
    for (int ks = 0; ks < 4; ++ks) af[ks] = *reinterpret_cast<const LAS bf16x8*>(As + (16 * tr + lr) * LDB + 32 * ks + 8 * g4);
    const int tcmax = (tr | 1);
#pragma unroll 1
    for (int tc = 0; tc <= tcmax; ++tc) { f32x4v acc = {0.f, 0.f, 0.f, 0.f};
#pragma unroll
      for (int ks = 0; ks < 4; ++ks) { const bf16x8 bfr = *reinterpret_cast<const LAS bf16x8*>(KB + (16 * tc + lr) * LDB + 32 * ks + 8 * g4);
        acc = __builtin_amdgcn_mfma_f32_16x16x32_bf16(af[ks], bfr, acc, 0, 0, 0); }
      const int j = 16 * tc + lr; const float gj = gc[j];
#pragma unroll
      for (int r = 0; r < 4; ++r) { const int i = 16 * tr + 4 * g4 + r; const float d = __expf(fminf(gc[i] - gj, 0.f));
        if (p == 0) LM[i * LDL + j] = (j < i) ? be[i] * acc[r] * d : 0.f; else IN[i * LDL + j] = (j <= i) ? acc[r] * d : 0.f; } } }
  __syncthreads();
  float X[64];
  if (wave < 4) {
    const int ch = (wave & 1) * 64 + lane; const bool isV = wave < 2; const LAS float* src = (isV ? VF : KF) + ch;
#pragma unroll
    for (int i = 0; i < 64; ++i) { const float sc = isV ? be[i] : be[i] * eg[i]; X[i] = src[i * LDF] * sc; if ((i & 7) == 7) asm volatile("" ::: "memory"); }
#pragma unroll
    for (int i = 1; i < 64; ++i) { float acc = X[i]; const LAS float* Lr = LM + i * LDL;
#pragma unroll
      for (int q = 0; q < (i + 3) / 4; ++q) { const f32x4v l4 = *reinterpret_cast<const LAS f32x4v*>(Lr + 4 * q);
        if (4 * q + 0 < i) FNMA(acc, l4.x, X[4 * q + 0]); if (4 * q + 1 < i) FNMA(acc, l4.y, X[4 * q + 1]); if (4 * q + 2 < i) FNMA(acc, l4.z, X[4 * q + 2]); if (4 * q + 3 < i) FNMA(acc, l4.w, X[4 * q + 3]); }
      X[i] = acc; asm volatile("" ::: "memory"); }
  } else {
    const int tq = tid - 256;
#pragma unroll 1
    for (int e = tq; e < 1024; e += 256) { const int f = e >> 6, l2 = e & 63, mt = f >> 3, kb = (f >> 1) & 3, s = f & 1, m = l2 & 31, h2 = l2 >> 5, t = 32 * mt + m, dk0 = 32 * kb + 16 * s + 4 * h2;
      const u32x2 a = *reinterpret_cast<const LAS u32x2*>(QB + t * LDB + dk0), bq = *reinterpret_cast<const LAS u32x2*>(QB + t * LDB + dk0 + 8); const float sc = eg[t];
      u32x4 o; o.x = pkbf(bflo(a.x) * sc, bfhi(a.x) * sc); o.y = pkbf(bflo(a.y) * sc, bfhi(a.y) * sc); o.z = pkbf(bflo(bq.x) * sc, bfhi(bq.x) * sc); o.w = pkbf(bflo(bq.y) * sc, bfhi(bq.y) * sc);
      *reinterpret_cast<u32x4*>(gop + OP_QG + (size_t)e * 16) = o; }
#pragma unroll 1
    for (int e = tq; e < 1024; e += 256) { const int f = e >> 6, l2 = e & 63, kbm = f >> 2, tb = (f >> 1) & 1, s = f & 1, m = l2 & 31, h2 = l2 >> 5, dk = 32 * kbm + m, tp0 = 32 * tb + 16 * s + 4 * h2;
      float v[8];
#pragma unroll
      for (int jj = 0; jj < 4; ++jj) { v[jj] = KF[(tp0 + jj) * LDF + dk] * ekl[tp0 + jj]; v[4 + jj] = KF[(tp0 + 8 + jj) * LDF + dk] * ekl[tp0 + 8 + jj]; }
      u32x4 o; o.x = pkbf(v[0], v[1]); o.y = pkbf(v[2], v[3]); o.z = pkbf(v[4], v[5]); o.w = pkbf(v[6], v[7]);
      *reinterpret_cast<u32x4*>(gop + OP_KG + (size_t)e * 16) = o; }
#pragma unroll 1
    for (int e = tq; e < 512; e += 256) { const int f = e >> 6, l2 = e & 63, mt = f >> 2, tb = (f >> 1) & 1, s = f & 1, m = l2 & 31, h2 = l2 >> 5, t = 32 * mt + m, tp0 = 32 * tb + 16 * s + 4 * h2;
      const f32x4v a = *reinterpret_cast<const LAS f32x4v*>(IN + t * LDL + tp0), bq = *reinterpret_cast<const LAS f32x4v*>(IN + t * LDL + tp0 + 8);
      u32x4 o; o.x = pkbf(a.x, a.y); o.y = pkbf(a.z, a.w); o.z = pkbf(bq.x, bq.y); o.w = pkbf(bq.z, bq.w);
      *reinterpret_cast<u32x4*>(gop + OP_IN + (size_t)e * 16) = o; }
  }
  __syncthreads();
  if (wave < 2) { const int dv = wave * 64 + lane, slice = dv >> 5, n = dv & 31;
#pragma unroll
    for (int tb = 0; tb < 2; ++tb)
#pragma unroll
      for (int h2 = 0; h2 < 2; ++h2) { u32x4 o0, o1;
        o0.x = pkbf(X[32 * tb + crow(0, h2)], X[32 * tb + crow(1, h2)]); o0.y = pkbf(X[32 * tb + crow(2, h2)], X[32 * tb + crow(3, h2)]);
        o0.z = pkbf(X[32 * tb + crow(4, h2)], X[32 * tb + crow(5, h2)]); o0.w = pkbf(X[32 * tb + crow(6, h2)], X[32 * tb + crow(7, h2)]);
        o1.x = pkbf(X[32 * tb + crow(8, h2)], X[32 * tb + crow(9, h2)]); o1.y = pkbf(X[32 * tb + crow(10, h2)], X[32 * tb + crow(11, h2)]);
        o1.z = pkbf(X[32 * tb + crow(12, h2)], X[32 * tb + crow(13, h2)]); o1.w = pkbf(X[32 * tb + crow(14, h2)], X[32 * tb + crow(15, h2)]);
        u32x4* dst = reinterpret_cast<u32x4*>(gu + (size_t)((slice * 2 + tb) * 64 + (h2 * 32 + n)) * 32); dst[0] = o0; dst[1] = o1; }
  } else if (wave < 4) { const int dk = (wave & 1) * 64 + lane;
#pragma unroll
    for (int i = 0; i < 64; ++i) VF[i * LDF + dk] = X[i]; }
  __syncthreads();
#pragma unroll 1
  for (int e = tid; e < 1024; e += 512) { const int f = e >> 6, l2 = e & 63, mt = f >> 3, kb = (f >> 1) & 3, s = f & 1, m = l2 & 31, h2 = l2 >> 5, t = 32 * mt + m, dk0 = 32 * kb + 16 * s + 4 * h2;
    const f32x4v a = *reinterpret_cast<const LAS f32x4v*>(VF + t * LDF + dk0), bq = *reinterpret_cast<const LAS f32x4v*>(VF + t * LDF + dk0 + 8);
    u32x4 o; o.x = pkbf(a.x, a.y); o.y = pkbf(a.z, a.w); o.z = pkbf(bq.x, bq.y); o.w = pkbf(bq.z, bq.w);
    *reinterpret_cast<u32x4*>(gop + OP_W + (size_t)e * 16) = o; }
  __syncthreads();
}
__device__ __forceinline__ void g1_phase(const Ctx& C) {
  for (int item = blockIdx.x; item < 2048; item += C.G) g1_item(C, item);
}

__device__ __forceinline__ bf16x8 pack8(const f32x16& x, int s) {
  u32x4 w; w.x = pkbf(x[8 * s + 0], x[8 * s + 1]); w.y = pkbf(x[8 * s + 2], x[8 * s + 3]); w.z = pkbf(x[8 * s + 4], x[8 * s + 5]); w.w = pkbf(x[8 * s + 6], x[8 * s + 7]);
  return __builtin_bit_cast(bf16x8, w);
}
#define GMFMA(a, b, c) __builtin_amdgcn_mfma_f32_32x32x16_bf16((a), (b), (c), 0, 0, 0)
__device__ __forceinline__ void g2_scan(const Ctx& C, int bh, int slice) {
  if (C.wave != 0) return;
  const int lane = C.lane, n = lane & 31, hh = lane >> 5, b = bh >> 2, h = bh & 3;
  constexpr int BUFB = 61440;
  const unsigned char* op0 = C.gop + (size_t)(bh * 32) * OPB + lane * 16; const unsigned char* u0 = C.gU + (size_t)(bh * 32) * UB + slice * 4096 + lane * 16;
#define G2_DMA(cc, bb) do { const unsigned char* _o = op0 + (size_t)(cc) * OPB; const unsigned char* _u = u0 + (size_t)(cc) * UB; LAS unsigned char* _d = C.lds + (bb) * BUFB; \
    _Pragma("unroll") for (int f = 0; f < 56; ++f) __builtin_amdgcn_global_load_lds((const unsigned*)(_o + f * 1024), (LAS unsigned*)(_d + f * 1024), 16, 0, 0); \
    _Pragma("unroll") for (int f = 0; f < 4; ++f) __builtin_amdgcn_global_load_lds((const unsigned*)(_u + f * 1024), (LAS unsigned*)(_d + 57344 + f * 1024), 16, 0, 0); } while (0)
  f32x16 S[4];
#pragma unroll
  for (int kb = 0; kb < 4; ++kb) S[kb] = f32x16{};
  G2_DMA(0, 0);
  float* og = C.og + (size_t)(b * SEQ) * 512 + h * 128 + slice * 32 + n;
#pragma unroll 1
  for (int c = 0; c < 32; ++c) {
    asm volatile("s_waitcnt vmcnt(0)" ::: "memory");
    if (c + 1 < 32) G2_DMA(c + 1, (c + 1) & 1);
    const LAS unsigned char* cur = C.lds + (c & 1) * BUFB + lane * 16;
    const float al = C.galast[bh * 32 + c];
    bf16x8 Sb[4][2];
#pragma unroll
    for (int kb = 0; kb < 4; ++kb) { Sb[kb][0] = pack8(S[kb], 0); Sb[kb][1] = pack8(S[kb], 1); }
    f32x16 P[2], O[2];
#pragma unroll
    for (int mt = 0; mt < 2; ++mt) { P[mt] = f32x16{}; O[mt] = f32x16{};
#pragma unroll
      for (int kb = 0; kb < 4; ++kb)
#pragma unroll
        for (int s = 0; s < 2; ++s) { const int f = (mt * 4 + kb) * 2 + s;
          const bf16x8 aw = *reinterpret_cast<const LAS bf16x8*>(cur + OP_W + f * 1024), aq = *reinterpret_cast<const LAS bf16x8*>(cur + OP_QG + f * 1024);
          P[mt] = GMFMA(aw, Sb[kb][s], P[mt]); O[mt] = GMFMA(aq, Sb[kb][s], O[mt]); } }
#pragma unroll
    for (int mt = 0; mt < 2; ++mt) { const LAS unsigned char* up = C.lds + (c & 1) * BUFB + 57344 + (mt * 64 + lane) * 32;
      const u32x4 ua = *reinterpret_cast<const LAS u32x4*>(up), ub = *reinterpret_cast<const LAS u32x4*>(up + 16);
      P[mt][0] = bflo(ua.x) - P[mt][0]; P[mt][1] = bfhi(ua.x) - P[mt][1]; P[mt][2] = bflo(ua.y) - P[mt][2]; P[mt][3] = bfhi(ua.y) - P[mt][3];
      P[mt][4] = bflo(ua.z) - P[mt][4]; P[mt][5] = bfhi(ua.z) - P[mt][5]; P[mt][6] = bflo(ua.w) - P[mt][6]; P[mt][7] = bfhi(ua.w) - P[mt][7];
      P[mt][8] = bflo(ub.x) - P[mt][8]; P[mt][9] = bfhi(ub.x) - P[mt][9]; P[mt][10] = bflo(ub.y) - P[mt][10]; P[mt][11] = bfhi(ub.y) - P[mt][11];
      P[mt][12] = bflo(ub.z) - P[mt][12]; P[mt][13] = bfhi(ub.z) - P[mt][13]; P[mt][14] = bflo(ub.w) - P[mt][14]; P[mt][15] = bfhi(ub.w) - P[mt][15]; }
    bf16x8 Vb[2][2];
#pragma unroll
    for (int tb = 0; tb < 2; ++tb) { Vb[tb][0] = pack8(P[tb], 0); Vb[tb][1] = pack8(P[tb], 1); }
#pragma unroll
    for (int mt = 0; mt < 2; ++mt) {
#pragma unroll
      for (int tb = 0; tb <= mt; ++tb)
#pragma unroll
        for (int s = 0; s < 2; ++s) { const int f = (mt * 2 + tb) * 2 + s; const bf16x8 ai = *reinterpret_cast<const LAS bf16x8*>(cur + OP_IN + f * 1024); O[mt] = GMFMA(ai, Vb[tb][s], O[mt]); }
#pragma unroll
      for (int r = 0; r < 16; ++r) og[(size_t)(64 * c + 32 * mt + crow(r, hh)) * 512] = O[mt][r]; }
#pragma unroll
    for (int kb = 0; kb < 4; ++kb) {
#pragma unroll
      for (int r = 0; r < 16; ++r) S[kb][r] *= al;
#pragma unroll
      for (int tb = 0; tb < 2; ++tb)
#pragma unroll
        for (int s = 0; s < 2; ++s) { const int f = (kb * 2 + tb) * 2 + s; const bf16x8 ak = *reinterpret_cast<const LAS bf16x8*>(cur + OP_KG + f * 1024); S[kb] = GMFMA(ak, Vb[tb][s], S[kb]); } }
  }
  asm volatile("s_waitcnt vmcnt(0)" ::: "memory");
#undef G2_DMA
}
#undef GMFMA
__device__ __forceinline__ void gnorm_phase(const Ctx& C) {
  const int lane = C.lane; const float on0 = C.o_norm[2 * lane], on1 = C.o_norm[2 * lane + 1];
  for (int m = C.gw; m < MROWS; m += C.NGW) {
#pragma unroll
    for (int h = 0; h < 4; ++h) { const fl2 o = *reinterpret_cast<const fl2*>(C.og + (size_t)m * 512 + h * 128 + 2 * lane);
      const float rstd = 1.0f / sqrtf(wave_sum(o.x * o.x + o.y * o.y) * (1.0f / 128.f) + EPS);
      const unsigned zu = *(const unsigned*)(C.proj + (size_t)m * NPROJ + PC_ZB + h * 128 + 2 * lane);
      *(unsigned*)(C.R1 + (size_t)m * KOUT + 1024 + h * 128 + 2 * lane) = pk2(o.x * rstd * on0 * silu_f(bflo(zu)), o.y * rstd * on1 * silu_f(bfhi(zu))); } }
}
}
__global__ void __launch_bounds__(512, 2) fwd(Args a) {
    extern __shared__ __attribute__((aligned(16))) unsigned char lds_raw[];
    Ctx C;
    C.lds = (LAS unsigned char*)lds_raw;
    C.tid = threadIdx.x; C.lane = C.tid & 63; C.wave = __builtin_amdgcn_readfirstlane(C.tid >> 6); C.G = gridDim.x; C.gw = blockIdx.x * 8 + C.wave; C.NGW = C.G * 8;
    C.x = a.in[0]; C.w_in = a.in[1]; C.c_norm = a.in[2]; C.w_uk = a.in[3]; C.w_uv = a.in[4]; C.rel_bias = a.in[5]; C.conv_w = a.in[6]; C.a_log = a.in[7]; C.dt_bias = a.in[8]; C.o_norm = a.in[9];
    C.w_out = a.in[10]; C.g_pre_mix = a.in[11]; C.g_post_mix = a.in[12]; C.g_pre_mlp = a.in[13]; C.g_post_mlp = a.in[14]; C.w_mi = a.in[15]; C.w_mo = a.in[16]; C.out = a.out;
    unsigned char* ws = a.ws;
    C.WinT = (bf16*)(ws + WS_WIN); C.WoutT = (bf16*)(ws + WS_WOUT); C.WmiT = (bf16*)(ws + WS_WMI); C.WmoT = (bf16*)(ws + WS_WMO); C.R1 = (bf16*)(ws + WS_R1); C.proj = (bf16*)(ws + WS_PROJ);
    C.cn = (bf16*)(ws + WS_CN); C.act = (bf16*)(ws + WS_ACT); C.small = (float*)(ws + WS_SMALL); C.mix = (float*)(ws + WS_MIX); C.y = (float*)(ws + WS_Y);
    C.gop = (unsigned char*)a.out; C.gU = ws + WS_GU; C.galast = (float*)(ws + WS_ALAST); C.og = (float*)(ws + WS_OG);
    volatile LAS unsigned* MISC = (volatile LAS unsigned*)(C.lds + MISC_OFF);
    if (C.tid < 16) MISC[C.tid] = 0u;
    __syncthreads();
    const int lo = a.ph_lo, hi = a.ph_hi;
    XcdBarrier bar; bar.bar = (unsigned*)(ws + WS_CTL) + CW_BAR; bar.x = 0; bar.st = nullptr;
    if (hi - lo > 1) bar = xcd_barrier_post((unsigned*)(ws + WS_CTL) + CW_BAR, MISC);
#define IN(k) (lo <= (k) && (k) < hi)
#define SEAM(k) do { if (IN(k) && IN((k) + 1)) xcd_barrier(bar); } while (0)

#ifndef NO_P0
    if (IN(0)) { p0_prologue(C); SEAM(0); }
#endif
#ifndef NO_GEMM
    if (IN(1)) { pg8::Gemm g{C.R1, C.WinT, MROWS, NPROJ, DM}; pg8::StaticOrder S; S.init(MROWS, NPROJ, C.G, (int)blockIdx.x);
        pg8::EpiProj E{C.proj, NPROJ, C.small};
        pg8::gemm_phase<pg8::EpiProj, pg8::StaticOrder, false>(C.lds, g, S, E, nullptr); SEAM(1); }
#endif
#ifdef GDN_NAIVE
    if (IN(2)) { p2_cn(C); if (blockIdx.x < 64) p2_gdn_seq(C, blockIdx.x >> 2, blockIdx.x & 3); SEAM(2); }
    if (IN(3)) { SEAM(3); }
#else
    if (IN(2)) { p2_cn(C);
#ifndef G1OFF
 gdn::g1_phase(C);
#endif
 SEAM(2); }
#ifndef G2OFF
    if (IN(3)) { if (C.G == 256) { const int x = blockIdx.x & 7, yy = blockIdx.x >> 3; gdn::g2_scan(C, x + 8 * (yy >> 2), yy & 3); }
                 else if (blockIdx.x < 256) gdn::g2_scan(C, blockIdx.x >> 2, blockIdx.x & 3);
                 SEAM(3); }
#endif
#endif
    if (IN(4)) {
#ifndef GDN_NAIVE
        gdn::gnorm_phase(C);
#endif
#ifdef DSA_NAIVE
        p3_dsa(C);
#else
#ifndef DSAOFF
        dsa::p3_dsa_mfma(C);
#endif
#endif
        SEAM(4); }
#ifndef NO_GEMM
    if (IN(5)) { pg8::Gemm g{C.R1, C.WoutT, MROWS, DM, KOUT}; pg8::StaticOrder S; S.init(MROWS, DM, C.G, (int)blockIdx.x);
        pg8::EpiF32 E{C.mix, DM, nullptr};
        pg8::gemm_phase<pg8::EpiF32, pg8::StaticOrder, false>(C.lds, g, S, E, nullptr); SEAM(5); }
#endif
    if (IN(6)) { p5_postnorm(C); SEAM(6); }
#ifndef NO_GEMM
    if (IN(7)) { pg8::Gemm g{C.R1, C.WmiT, MROWS, DFF, DM}; pg8::StaticOrder S; S.init(MROWS, DFF, C.G, (int)blockIdx.x);
        pg8::EpiRelu2 E{C.act, DFF};
        pg8::gemm_phase<pg8::EpiRelu2, pg8::StaticOrder, false>(C.lds, g, S, E, nullptr); SEAM(7); }
    if (IN(8)) { pg8::Gemm g{C.act, C.WmoT, MROWS, DM, DFF}; pg8::StaticOrder S; S.init(MROWS, DM, C.G, (int)blockIdx.x);
        pg8::EpiF32 E{C.y, DM, nullptr};
        pg8::gemm_phase<pg8::EpiF32, pg8::StaticOrder, false>(C.lds, g, S, E, nullptr); SEAM(8); }
#endif
    if (IN(9)) { p8_final(C); }
#undef IN
#undef SEAM
}

extern "C" void kernel_launch(void* const* d_in, const int* in_sizes, int n_in, void* d_out, int out_size, void* d_ws, size_t ws_size, hipStream_t stream) {
    static int grid = 0;
    if (grid == 0) {
        if (n_in != 17 || in_sizes[0] != MROWS * DM || out_size != MROWS * DM || ws_size < WS_END) {
            fprintf(stderr, "kernel_launch: built for 17 inputs, x/out of %d floats, >= %zu bytes of workspace; got n_in %d, in0 %d, out %d, ws %zu; nothing launched\n", MROWS * DM, (size_t)WS_END, n_in, n_in > 0 ? in_sizes[0] : -1, out_size, ws_size); grid = -1; return; }
        int dev = 0, cus = 0, per_cu = 0;
        if (hipGetDevice(&dev) != hipSuccess || hipDeviceGetAttribute(&cus, hipDeviceAttributeMultiprocessorCount, dev) != hipSuccess) { fprintf(stderr, "kernel_launch: device query failed\n"); grid = -1; return; }
        if (hipFuncSetAttribute((const void*)fwd, hipFuncAttributeMaxDynamicSharedMemorySize, LDS_BYTES) != hipSuccess) { fprintf(stderr, "kernel_launch: hipFuncSetAttribute failed\n"); grid = -1; return; }
        if (hipOccupancyMaxActiveBlocksPerMultiprocessor(&per_cu, (const void*)fwd, 512, LDS_BYTES) != hipSuccess || per_cu < 1)
            fprintf(stderr, "kernel_launch: note: occupancy query reports %d workgroups per CU\n", per_cu);
        (void)hipGetLastError();
        grid = cus;
        if (grid < 64) { fprintf(stderr, "kernel_launch: needs >= 64 CUs\n"); grid = -1; return; }
    }
    if (grid < 0) return;
    if (hipMemsetAsync((char*)d_ws + WS_CTL, 0, CTL_ZERO_BYTES, stream) != hipSuccess) { fprintf(stderr, "kernel_launch: memset failed\n"); return; }
    Args a{};
    for (int i = 0; i < 17; ++i) a.in[i] = (const float*)d_in[i];
    a.out = (float*)d_out; a.ws = (unsigned char*)d_ws;
    if (MK_N_LAUNCHES == 1) { a.ph_lo = 0; a.ph_hi = NPHASE; hipLaunchKernelGGL(fwd, dim3(grid), dim3(512), LDS_BYTES, stream, a); }
    else for (int p = 0; p < NPHASE; ++p) { a.ph_lo = p; a.ph_hi = p + 1; hipLaunchKernelGGL(fwd, dim3(grid), dim3(512), LDS_BYTES, stream, a); }
    const hipError_t le = hipPeekAtLastError();
    if (le != hipSuccess) fprintf(stderr, "kernel_launch: launch failed: %s\n", hipGetErrorName(le));
}
```

```cpp
#include <hip/hip_runtime.h>
#include <cstdio>
#include <cstdint>
namespace pg8 {
#define PG8_LAS __attribute__((address_space(3)))
typedef unsigned short bf16_t;
typedef short bf16x8 __attribute__((ext_vector_type(8)));
typedef float f32x4 __attribute__((ext_vector_type(4)));
typedef unsigned u32x4 __attribute__((ext_vector_type(4)));
constexpr int BM = 256, BK = 64, HALF = 128, HTB = HALF * BK * 2  , STAGE_BYTES = 8 * HTB, NXCD = 8, WGM = 8;

__host__ __device__ __forceinline__ int lds_byte(int r, int c) { const int st = (r >> 4) * 2 + (c >> 5), rr = r & 15, cc = c & 31, ob = rr * 64 + cc * 2; return st * 1024 + (ob ^ (((ob >> 9) & 1) << 5)); }
__host__ __device__ __forceinline__ void stage_rc(int b, int& R, int& C) { const int st = b / 1024, sb = b % 1024, swz = sb ^ (((sb >> 9) & 1) << 5); R = (st >> 1) * 16 + swz / 64; C = (st & 1) * 32 + (swz % 64) / 2; }
__host__ __device__ __forceinline__ int perm32(int rho) { const int n = rho >> 4, i = rho & 15; return 8 * (i >> 2) + 4 * n + (i & 3); }

struct Unit { int pm, pn; };
struct Gemm { const bf16_t* A; const bf16_t* Bt; int M, N, K; };

struct StaticOrder {
    int nM, nN, nwg, G, c;
    __host__ __device__ void init(int M, int N, int G_, int c_) { nM = M / BM; nN = N / BM; nwg = nM * nN; G = G_; c = c_; }
    __host__ __device__ bool next(int i, Unit& u) const {
        const long L = (long)i * G + c; if (L >= nwg) return false;
        int wgid = (int)L; { const int q = nwg / NXCD, r = nwg % NXCD, xcd = wgid % NXCD, off = wgid / NXCD; wgid = (xcd < r ? xcd * (q + 1) : r * (q + 1) + (xcd - r) * q) + off; }
        const int nig = WGM * nN, gid = wgid / nig, fm = gid * WGM, gsz = (nM - fm) < WGM ? (nM - fm) : WGM;
        u.pm = fm + ((wgid % nig) % gsz); u.pn = (wgid % nig) / gsz; return true;
    }
    __device__ __forceinline__ void a_ready(const Unit&) const {}
    __device__ __forceinline__ void done(const Unit&) const {}
};
__device__ __forceinline__ unsigned cvt_pk_bf16(float lo, float hi) { unsigned r; asm volatile("v_cvt_pk_bf16_f32 %0, %1, %2" : "=v"(r) : "v"(lo), "v"(hi)); return r; }
typedef float f32x2 __attribute__((ext_vector_type(2)));
struct EpiF32 {
    static constexpr bool PERM = false, AFTER_DRAIN = false;
    float* C; int ldc; const float* bias;
    __device__ __forceinline__ void operator()(const f32x4 (&acc)[2][2][4][2], const Unit& u, int wr, int wc, int fr, int fq) const {
        const int row0 = u.pm * BM + wr * 64 + fr, col0 = u.pn * BM + wc * 32 + 4 * fq;
        f32x4 bv[2][2];
#pragma unroll
        for (int bj = 0; bj < 2; ++bj)
#pragma unroll
            for (int n = 0; n < 2; ++n) bv[bj][n] = bias ? *(const f32x4*)(bias + col0 + bj * HALF + n * 16) : (f32x4){0.f, 0.f, 0.f, 0.f};
#pragma unroll
        for (int ai = 0; ai < 2; ++ai)
#pragma unroll
            for (int m = 0; m < 4; ++m) { float* rowp = C + (size_t)(row0 + ai * HALF + m * 16) * ldc + col0;
#pragma unroll
                for (int bj = 0; bj < 2; ++bj)
#pragma unroll
                    for (int n = 0; n < 2; ++n) *(f32x4*)(rowp + bj * HALF + n * 16) = acc[ai][bj][m][n] + bv[bj][n]; }
    }
};
struct EpiProj {
    static constexpr bool PERM = true, AFTER_DRAIN = false;
    bf16_t* O; int ldc; float* small;
    __device__ __forceinline__ void operator()(const f32x4 (&acc)[2][2][4][2], const Unit& u, int wr, int wc, int fr, int fq) const {
        const int row0 = u.pm * BM + wr * 64 + fr, col0 = u.pn * BM + wc * 32 + 8 * fq;
#pragma unroll
        for (int ai = 0; ai < 2; ++ai)
#pragma unroll
            for (int m = 0; m < 4; ++m) { bf16_t* rowp = O + (size_t)(row0 + ai * HALF + m * 16) * ldc + col0;
#pragma unroll
                for (int bj = 0; bj < 2; ++bj) { const f32x4 v0 = acc[ai][bj][m][0], v1 = acc[ai][bj][m][1];
                    u32x4 w; w.x = cvt_pk_bf16(v0[0], v0[1]); w.y = cvt_pk_bf16(v0[2], v0[3]); w.z = cvt_pk_bf16(v1[0], v1[1]); w.w = cvt_pk_bf16(v1[2], v1[3]);
                    *(u32x4*)(rowp + bj * HALF) = w; } }
        if (u.pn == 4 && wc == 2 && fq < 2) {
#pragma unroll
            for (int ai = 0; ai < 2; ++ai)
#pragma unroll
                for (int m = 0; m < 4; ++m) { float* sp = small + (size_t)(row0 + ai * HALF + m * 16) * 16 + 8 * fq;
                    *(f32x4*)sp = acc[ai][1][m][0]; *(f32x4*)(sp + 4) = acc[ai][1][m][1]; }
        }
    }
};
struct EpiRelu2 {
    static constexpr bool PERM = true, AFTER_DRAIN = false;
    bf16_t* O; int ldc;
    __device__ __forceinline__ void operator()(const f32x4 (&acc)[2][2][4][2], const Unit& u, int wr, int wc, int fr, int fq) const {
        const int row0 = u.pm * BM + wr * 64 + fr, col0 = u.pn * BM + wc * 32 + 8 * fq;
#pragma unroll
        for (int ai = 0; ai < 2; ++ai)
#pragma unroll
            for (int m = 0; m < 4; ++m) { bf16_t* rowp = O + (size_t)(row0 + ai * HALF + m * 16) * ldc + col0;
#pragma unroll
                for (int bj = 0; bj < 2; ++bj) { f32x4 v0 = acc[ai][bj][m][0], v1 = acc[ai][bj][m][1];
#pragma unroll
                    for (int j = 0; j < 4; ++j) { const float a = fmaxf(v0[j], 0.f), b = fmaxf(v1[j], 0.f); v0[j] = a * a; v1[j] = b * b; }
                    u32x4 w; w.x = cvt_pk_bf16(v0[0], v0[1]); w.y = cvt_pk_bf16(v0[2], v0[3]); w.z = cvt_pk_bf16(v1[0], v1[1]); w.w = cvt_pk_bf16(v1[2], v1[3]);
                    *(u32x4*)(rowp + bj * HALF) = w; } }
    }
};
template <class Epi, class Sched, bool STAMP = false>
__device__ __forceinline__ void gemm_phase(PG8_LAS unsigned char* lds, const Gemm g, const Sched& S, const Epi& E, unsigned long long* stamps) {
    const int tid = threadIdx.x, wid = __builtin_amdgcn_readfirstlane(tid >> 6), lane = tid & 63, wr = wid >> 2, wc = wid & 3, fr = lane & 15, fq = lane >> 4;
    const int K = g.K, nt = K / BK;
    int ts_lo = 0, ts_hi = 0, nts = 0; const unsigned long long rt_entry = STAMP ? (unsigned long long)wall_clock64() : 0ull;
#define PG8_STAMP() do { if (STAMP && wid == 0 && nts < 64) { const unsigned long long _c = (unsigned long long)clock64(); \
        ts_lo = (lane == nts) ? (int)(unsigned)_c : ts_lo; ts_hi = (lane == nts) ? (int)(unsigned)(_c >> 32) : ts_hi; ++nts; } } while (0)
    PG8_STAMP();
    unsigned voffA[2], voffB[2];
#pragma unroll
    for (int i = 0; i < 2; ++i) { int R, C; stage_rc(tid * 16 + i * 8192, R, C); const int Rb = Epi::PERM ? ((R & ~31) + perm32(R & 31)) : R;
        voffA[i] = (unsigned)(R * K + C) * 2u; voffB[i] = (unsigned)(Rb * K + C) * 2u; }
    const size_t kstep = (size_t)(BK * 2);
    const size_t hstep = (size_t)HALF * K * 2;
    const size_t tstep = 2 * hstep;
    const unsigned ldsw = (unsigned)wid * 1024u;
    const int aoff = lds_byte(wr * 64 + fr, fq * 8), boff = lds_byte(wc * 32 + fr, fq * 8);
#define PG8_SA(b, h) (((b) * 2 + (h)) * HTB)
#define PG8_SB(b, h) ((4 + (b) * 2 + (h)) * HTB)
#define PG8_STAGE(bufoff, gbase, voff) do { _Pragma("unroll") for (int _i = 0; _i < 2; ++_i) \
        __builtin_amdgcn_global_load_lds((const unsigned*)((const char*)(gbase) + (voff)[_i]), (PG8_LAS unsigned*)(lds + (bufoff) + ldsw + _i * 8192), 16, 0, 0); } while (0)
#define PG8_LDA(dst, b, h) do { _Pragma("unroll") for (int m = 0; m < 4; ++m) _Pragma("unroll") for (int k = 0; k < 2; ++k) dst[m][k] = *(const PG8_LAS bf16x8*)(lds + PG8_SA(b, h) + aoff + m * 2048 + k * 1024); } while (0)
#define PG8_LDB(dst, b, h) do { _Pragma("unroll") for (int n = 0; n < 2; ++n) _Pragma("unroll") for (int k = 0; k < 2; ++k) dst[n][k] = *(const PG8_LAS bf16x8*)(lds + PG8_SB(b, h) + boff + n * 2048 + k * 1024); } while (0)
#define PG8_MMA(ai, bj, At, Bt) do { __builtin_amdgcn_s_setprio(1); _Pragma("unroll") for (int m = 0; m < 4; ++m) _Pragma("unroll") for (int n = 0; n < 2; ++n) _Pragma("unroll") for (int k = 0; k < 2; ++k) \
        acc[ai][bj][m][n] = __builtin_amdgcn_mfma_f32_16x16x32_bf16(Bt[n][k], At[m][k], acc[ai][bj][m][n], 0, 0, 0); __builtin_amdgcn_s_setprio(0); } while (0)
#define PG8_WAIT_V(n) asm volatile("s_waitcnt vmcnt(" #n ")" ::: "memory")
#define PG8_WAIT_L(n) asm volatile("s_waitcnt lgkmcnt(" #n ")" ::: "memory")
#define PG8_BAR __builtin_amdgcn_s_barrier()
#define PG8_SCHED __builtin_amdgcn_sched_barrier(0)
    Unit cur, nxt; int ui = 0;
    if (!S.next(0, cur)) return;
    f32x4 acc[2][2][4][2];
#pragma unroll
    for (int a = 0; a < 2; ++a)
#pragma unroll
        for (int b = 0; b < 2; ++b)
#pragma unroll
            for (int m = 0; m < 4; ++m)
#pragma unroll
                for (int n = 0; n < 2; ++n) acc[a][b][m][n] = (f32x4){0.f, 0.f, 0.f, 0.f};
    bf16x8 At[4][2], B0[2][2], B1[2][2];
    const char* cA = (const char*)g.A + (size_t)cur.pm * tstep; const char* cB = (const char*)g.Bt + (size_t)cur.pn * tstep;
    S.a_ready(cur);
    PG8_STAGE(PG8_SB(0, 0), cB, voffB); PG8_STAGE(PG8_SA(0, 0), cA, voffA); PG8_STAGE(PG8_SB(0, 1), cB + hstep, voffB); PG8_STAGE(PG8_SA(0, 1), cA + hstep, voffA);
    if (wr == 1) PG8_BAR;
    PG8_WAIT_V(4); PG8_BAR;
    PG8_STAGE(PG8_SB(1, 0), cB + kstep, voffB); PG8_STAGE(PG8_SA(1, 0), cA + kstep, voffA); PG8_STAGE(PG8_SB(1, 1), cB + hstep + kstep, voffB);
    PG8_WAIT_V(6); PG8_BAR;
    PG8_STAMP();
    for (;;) {
        const bool has_next = S.next(ui + 1, nxt);
        const char* nA = has_next ? (const char*)g.A + (size_t)nxt.pm * tstep : cA; const char* nB = has_next ? (const char*)g.Bt + (size_t)nxt.pn * tstep : cB;
        for (int t = 0; t < nt; t += 2) {
            const bool last = (t == nt - 2);
            const char* a1 = cA + (size_t)(t + 1) * kstep;
            const char* a2 = last ? nA : cA + (size_t)(t + 2) * kstep; const char* b2 = last ? nB : cB + (size_t)(t + 2) * kstep;
            const char* a3 = a2 + kstep; const char* b3 = b2 + kstep;
            if (last && has_next) S.a_ready(nxt);
            PG8_LDB(B0, 0, 0); PG8_SCHED; PG8_LDA(At, 0, 0); PG8_STAGE(PG8_SA(1, 1), a1 + hstep, voffA);
            PG8_WAIT_L(8); PG8_BAR; PG8_WAIT_L(0); PG8_MMA(0, 0, At, B0); PG8_BAR; PG8_SCHED;
            PG8_LDB(B1, 0, 1); PG8_STAGE(PG8_SB(0, 0), b2, voffB);
            PG8_BAR; PG8_WAIT_L(0); PG8_MMA(0, 1, At, B1); PG8_BAR;
            PG8_LDA(At, 0, 1); PG8_STAGE(PG8_SA(0, 0), a2, voffA);
            PG8_BAR; PG8_WAIT_L(0); PG8_MMA(1, 0, At, B0); PG8_BAR; PG8_SCHED;
            PG8_STAGE(PG8_SB(0, 1), b2 + hstep, voffB);
            PG8_WAIT_V(6); PG8_BAR; PG8_MMA(1, 1, At, B1); PG8_BAR;
            PG8_LDB(B0, 1, 0); PG8_SCHED; PG8_LDA(At, 1, 0); PG8_STAGE(PG8_SA(0, 1), a2 + hstep, voffA);
            PG8_WAIT_L(8); PG8_BAR; PG8_WAIT_L(0); PG8_MMA(0, 0, At, B0); PG8_BAR; PG8_SCHED;
            PG8_LDB(B1, 1, 1); PG8_STAGE(PG8_SB(1, 0), b3, voffB);
            PG8_BAR; PG8_WAIT_L(0); PG8_MMA(0, 1, At, B1); PG8_BAR;
            PG8_LDA(At, 1, 1); PG8_STAGE(PG8_SA(1, 0), a3, voffA);
            PG8_BAR; PG8_WAIT_L(0); PG8_MMA(1, 0, At, B0); PG8_BAR; PG8_SCHED;
            PG8_STAGE(PG8_SB(1, 1), b3 + hstep, voffB);
            PG8_WAIT_V(6); PG8_BAR; PG8_MMA(1, 1, At, B1); PG8_BAR;
        }
        PG8_STAMP();
        if constexpr (!Epi::AFTER_DRAIN) { E(acc, cur, wr, wc, fr, fq); S.done(cur); }
        PG8_STAMP();
        if (!has_next) break;
#pragma unroll
        for (int a = 0; a < 2; ++a)
#pragma unroll
            for (int b = 0; b < 2; ++b)
#pragma unroll
                for (int m = 0; m < 4; ++m)
#pragma unroll
                    for (int n = 0; n < 2; ++n) acc[a][b][m][n] = (f32x4){0.f, 0.f, 0.f, 0.f};
        cur = nxt; cA = nA; cB = nB; ++ui;
    }
    PG8_WAIT_V(0);
    if (wr == 0) PG8_BAR;
    PG8_BAR;
    if constexpr (Epi::AFTER_DRAIN) { E.fused(acc, cur, wr, wc, fr, fq, lds, wid, lane); S.done(cur); }
    PG8_STAMP();
    if (STAMP && wid == 0) { stamps[lane] = lane < nts ? (((unsigned long long)(unsigned)ts_hi << 32) | (unsigned)ts_lo) : 0ull;
        if (lane == 62) stamps[62] = rt_entry; if (lane == 63) stamps[63] = (unsigned long long)wall_clock64(); }
#undef PG8_STAMP
#undef PG8_SA
#undef PG8_SB
#undef PG8_STAGE
#undef PG8_LDA
#undef PG8_LDB
#undef PG8_MMA
#undef PG8_WAIT_V
#undef PG8_WAIT_L
#undef PG8_BAR
#undef PG8_SCHED
}
}
#define XB_TMO      128
#define XB_XCNT(j)  (256  + 64 * (j))
#define XB_XSUB(j)  (1280 + 64 * (j))
#define XB_XGEN(j)  (2304 + 64 * (j))
#define XB_TOP      3328
#define XB_TOPGEN   3392
#define XCD_BAR_WORDS 3456
#define XB_SPIN_CAP (1u << 18)
#define LAS __attribute__((address_space(3)))

__device__ __forceinline__ unsigned xb_ld(unsigned* p)              { return __hip_atomic_load(p, __ATOMIC_RELAXED, __HIP_MEMORY_SCOPE_AGENT); }
__device__ __forceinline__ unsigned xb_add(unsigned* p, unsigned v) { return __hip_atomic_fetch_add(p, v, __ATOMIC_RELAXED, __HIP_MEMORY_SCOPE_AGENT); }
__device__ __forceinline__ unsigned xb_xcc_id() { return (unsigned)__builtin_amdgcn_s_getreg((3 << 11) | 20) & 0xFu; }
#define XB_SPIN(cond, bar) do { unsigned _sp = 0; while (cond) { __builtin_amdgcn_s_sleep(1); \
    if ((++_sp & 255u) == 0u) { if (xb_ld(&(bar)[XB_TMO])) break; if (_sp > XB_SPIN_CAP) { atomicAdd(&(bar)[XB_TMO], 1u); break; } } } } while (0)

struct XcdBarrier {
    unsigned* bar; unsigned x;
    volatile LAS unsigned* st;
};

__device__ __forceinline__ XcdBarrier xcd_barrier_post(unsigned* bar, volatile LAS unsigned* st) {
    XcdBarrier b; b.bar = bar; b.x = xb_xcc_id(); b.st = st;
    if (threadIdx.x == 0) (void)xb_add(&bar[XB_XCNT(b.x)], 1u);
    return b;
}
__device__ __forceinline__ void xcd_barrier_complete(unsigned* bar, unsigned x, unsigned& nloc, unsigned& nx) {
    const unsigned G = gridDim.x * gridDim.y * gridDim.z;
    unsigned sum, cnt, mine, sp = 0u;
    for (;;) {
        sum = 0u; cnt = 0u; mine = 0u;
#pragma unroll
        for (unsigned j = 0; j < 16; ++j) { const unsigned c = xb_ld(&bar[XB_XCNT(j)]); sum += c; cnt += (c > 0u) ? 1u : 0u; mine = (j == x) ? c : mine; }
        if (sum == G) break;
        __builtin_amdgcn_s_sleep(1);
        if ((++sp & 255u) == 0u) { if (xb_ld(&bar[XB_TMO])) break; if (sp > XB_SPIN_CAP) { atomicAdd(&bar[XB_TMO], 1u); break; } }
    }
    nloc = mine > 0u ? mine : 1u; nx = cnt > 0u ? cnt : 1u;
}

__device__ __forceinline__ void xcd_barrier(const XcdBarrier& b) {
    asm volatile("s_waitcnt vmcnt(0)" ::: "memory");
    __syncthreads();
    if (threadIdx.x == 0) {
        unsigned* bar = b.bar;
        __builtin_amdgcn_s_waitcnt(0);
        unsigned nloc = b.st[0], nx = b.st[1];
        if (nloc == 0u) { xcd_barrier_complete(bar, b.x, nloc, nx); b.st[0] = nloc; b.st[1] = nx; }
        const unsigned old = xb_add(&bar[XB_XSUB(b.x)], 1u);
        const unsigned gen = old / nloc;
        if (old + 1u == (gen + 1u) * nloc) {
            __builtin_amdgcn_fence(__ATOMIC_RELEASE, "agent");
            asm volatile("s_waitcnt vmcnt(0)" ::: "memory");
            const unsigned og = xb_add(&bar[XB_TOP], 1u);
            const unsigned tg = og / nx;
            if (og + 1u == (tg + 1u) * nx) xb_add(&bar[XB_TOPGEN], 1u);
            else XB_SPIN(xb_ld(&bar[XB_TOPGEN]) == tg, bar);
            __builtin_amdgcn_fence(__ATOMIC_ACQUIRE, "agent");
            xb_add(&bar[XB_XGEN(b.x)], 1u);
            asm volatile("s_waitcnt vmcnt(0)" ::: "memory");
        } else {
            XB_SPIN(xb_ld(&bar[XB_XGEN(b.x)]) == gen, bar);
            __builtin_amdgcn_fence(__ATOMIC_ACQUIRE, "agent");
            asm volatile("s_waitcnt vmcnt(0)" ::: "memory");
        }
    }
    __syncthreads();
}
#ifndef MK_N_LAUNCHES
#define MK_N_LAUNCHES 1
#endif
constexpr int NPHASE = 10;
constexpr int BATCH = 16, SEQ = 2048, DM = 1024, MROWS = BATCH * SEQ, NPROJ = 3840, DFF = 4096, KOUT = 1536, INC = 3280;
constexpr float EPS = 1e-6f;
constexpr int PC_QABS = 0, PC_CKV = 1024, PC_KIDX = 1152, PC_SMALL = 1216, PC_QIDX = 1280, PC_QB = 1792, PC_KB = 2304, PC_VB = 2816, PC_ZB = 3328;
constexpr size_t MiB = 1u << 20;
constexpr size_t WS_CTL = 0, CTL_ZERO_BYTES = 1 * MiB;
constexpr size_t WS_WMI = 1 * MiB, WS_WMO = 9 * MiB, WS_R1 = 17 * MiB, WS_WOUT = 113 * MiB, WS_WIN = 116 * MiB, WS_SMALL = 124 * MiB, WS_CN = 126 * MiB, WS_PROJ = 134 * MiB;
constexpr size_t WS_MIX = 134 * MiB, WS_ACT = 116 * MiB, WS_Y = 372 * MiB, WS_END = 500 * MiB;
constexpr size_t WS_GU = 374 * MiB, WS_OG = 406 * MiB, WS_ALAST = 470 * MiB;
constexpr int CW_BAR = 4096;
constexpr int LDS_BYTES = 147456, MISC_OFF = LDS_BYTES - 64;

typedef unsigned short bf16;
typedef unsigned v4u __attribute__((ext_vector_type(4)));
typedef float f32x4 __attribute__((ext_vector_type(4)));
typedef float f32x2 __attribute__((ext_vector_type(2)));
#define LDS_WAIT() asm volatile("s_waitcnt lgkmcnt(0)" ::: "memory")
__device__ __forceinline__ unsigned f2bf(float f) { unsigned u = __float_as_uint(f); return (u + 0x7fffu + ((u >> 16) & 1u)) >> 16; }
__device__ __forceinline__ unsigned pk2(float lo, float hi) { return f2bf(lo) | (f2bf(hi) << 16); }
__device__ __forceinline__ float bflo(unsigned u) { return __uint_as_float(u << 16); }
__device__ __forceinline__ float bfhi(unsigned u) { return __uint_as_float(u & 0xffff0000u); }
__device__ __forceinline__ float bf2f(bf16 b) { return __uint_as_float(((unsigned)b) << 16); }
__device__ __forceinline__ float wave_sum(float v) {
    v += __builtin_bit_cast(float, __builtin_amdgcn_update_dpp(0, __builtin_bit_cast(int, v), 0xB1, 0xF, 0xF, true));
    v += __builtin_bit_cast(float, __builtin_amdgcn_update_dpp(0, __builtin_bit_cast(int, v), 0x4E, 0xF, 0xF, true));
    v += __builtin_bit_cast(float, __builtin_amdgcn_update_dpp(0, __builtin_bit_cast(int, v), 0x141, 0xF, 0xF, true));
    v += __builtin_bit_cast(float, __builtin_amdgcn_update_dpp(0, __builtin_bit_cast(int, v), 0x140, 0xF, 0xF, true));
    { const auto r = __builtin_amdgcn_permlane16_swap(__float_as_uint(v), __float_as_uint(v), false, false); const unsigned r0 = r[0], r1 = r[1]; v = __uint_as_float(r0) + __uint_as_float(r1); }
    { const auto r = __builtin_amdgcn_permlane32_swap(__float_as_uint(v), __float_as_uint(v), false, false); const unsigned r0 = r[0], r1 = r[1]; v = __uint_as_float(r0) + __uint_as_float(r1); }
    return v;
}
__device__ __forceinline__ float wave_max(float v) {
#pragma unroll
    for (int o = 1; o < 64; o <<= 1) v = fmaxf(v, __shfl_xor(v, o));
    return v;
}
__device__ __forceinline__ float silu_f(float x) { return x / (1.0f + __expf(-x)); }
__device__ __forceinline__ float sigmoid_f(float x) { return 1.0f / (1.0f + __expf(-x)); }
__device__ __forceinline__ float softplus_f(float x) { return fmaxf(x, 0.f) + log1pf(__expf(-fabsf(x))); }
__device__ __forceinline__ int t5_bucket(int rel) {
    const int side = rel > 0 ? 16 : 0, n = rel < 0 ? -rel : rel;
    int bk;
    if (n < 8) bk = n; else bk = 8 + (n >= 12) + (n >= 16) + (n >= 23) + (n >= 32) + (n >= 46) + (n >= 64) + (n >= 91);
    return side + bk;
}

struct Args { const float* in[17]; float* out; unsigned char* ws; int ph_lo, ph_hi, dup, pad; };
struct Ctx {
    int tid, lane, wave, G, gw, NGW, dup;
    LAS unsigned char* lds;
    const float *x, *w_in, *c_norm, *w_uk, *w_uv, *rel_bias, *conv_w, *a_log, *dt_bias, *o_norm, *w_out, *g_pre_mix, *g_post_mix, *g_pre_mlp, *g_post_mlp, *w_mi, *w_mo;
    float* out;
    bf16 *WinT, *WoutT, *WmiT, *WmoT, *R1, *proj, *cn, *act;
    float *small, *mix, *y;
    unsigned char *gop, *gU; float *galast, *og;
};

__device__ __forceinline__ void tr_item(const float* W, int ldsrc, int sc0, bf16* WT, int ldd, int dr0, int dc0, float scale, LAS float* scr, int kb, int nb, int lane) {
    const int k0 = 64 * kb, n0 = 32 * nb;
#pragma unroll 8
    for (int i = 0; i < 32; ++i) { const int kk = 2 * i + (lane >> 5); scr[kk * 33 + (lane & 31)] = W[(size_t)(k0 + kk) * ldsrc + sc0 + n0 + (lane & 31)]; }
    LDS_WAIT();
    const int c = lane & 7;
#pragma unroll
    for (int j = 0; j < 4; ++j) { const int n = (lane >> 3) + 8 * j; const LAS float* s = scr + (8 * c) * 33 + n;
        v4u o; o.x = pk2(s[0 * 33] * scale, s[1 * 33] * scale); o.y = pk2(s[2 * 33] * scale, s[3 * 33] * scale); o.z = pk2(s[4 * 33] * scale, s[5 * 33] * scale); o.w = pk2(s[6 * 33] * scale, s[7 * 33] * scale);
        *(v4u*)(WT + (size_t)(dr0 + n0 + n) * ldd + dc0 + k0 + 8 * c) = o; }
    LDS_WAIT();
}
__device__ __forceinline__ void rms_row_to_bf16(const float* xrow, const float* g, bf16* orow, int lane) {
    const f32x4* xr = (const f32x4*)xrow + lane; const f32x4* gr = (const f32x4*)g + lane;
    f32x4 v[4]; float s = 0.f;
#pragma unroll
    for (int j = 0; j < 4; ++j) { v[j] = xr[64 * j]; s += (v[j].x * v[j].x + v[j].y * v[j].y) + (v[j].z * v[j].z + v[j].w * v[j].w); }
    const float rstd = 1.0f / sqrtf(wave_sum(s) * (1.0f / DM) + EPS);
    unsigned long long* o8 = (unsigned long long*)orow + lane;
#pragma unroll
    for (int j = 0; j < 4; ++j) { const f32x4 gg = gr[64 * j];
        o8[64 * j] = (unsigned long long)pk2(v[j].x * rstd * gg.x, v[j].y * rstd * gg.y) | ((unsigned long long)pk2(v[j].z * rstd * gg.z, v[j].w * rstd * gg.w) << 32); }
}
__device__ __forceinline__ void p0_prologue(const Ctx& C) {
    LAS float* scr = (LAS float*)(C.lds + C.wave * 8704);
    const int lane = C.lane;
    const int d0_ = 1 + (C.dup & 1);
    for (int it = C.gw; it < 6496 * d0_; it += C.NGW) {
        int r = it % 6496;
        if (r < 64)   { tr_item(C.w_in, INC, 512, C.WinT, DM, PC_CKV, 0, 1.f, scr, r / 4, r % 4, lane); continue; } r -= 64;
        if (r < 32)   { tr_item(C.w_in, INC, 1152, C.WinT, DM, PC_KIDX, 0, 1.f, scr, r / 2, r % 2, lane); continue; } r -= 32;
        if (r < 256)  { tr_item(C.w_in, INC, 640, C.WinT, DM, PC_QIDX, 0, 0.125f, scr, r / 16, r % 16, lane); continue; } r -= 256;
        if (r < 768)  { tr_item(C.w_in, INC, 1224, C.WinT, DM, PC_QB, 0, 1.f, scr, r / 48, r % 48, lane); continue; } r -= 768;
        if (r < 256)  { tr_item(C.w_in, INC, 2768, C.WinT, DM, PC_ZB, 0, 1.f, scr, r / 16, r % 16, lane); continue; } r -= 256;
        if (r < 256)  { tr_item(C.w_out + 512 * 1024, DM, 0, C.WoutT, KOUT, 0, 1024, 1.f, scr, r / 32, r % 32, lane); continue; } r -= 256;
        if (r < 2048) { tr_item(C.w_mi, DFF, 0, C.WmiT, DM, 0, 0, 1.f, scr, r / 128, r % 128, lane); continue; } r -= 2048;
        if (r < 2048) { tr_item(C.w_mo, DM, 0, C.WmoT, DFF, 0, 0, 1.f, scr, r / 32, r % 32, lane); continue; } r -= 2048;
        if (r < 512) {
            const int hh = r / 64, rem = r % 64, kblk = rem / 4, cq = rem % 4, k = kblk * 64 + lane;
            float wr[64]; const f32x4* src = (const f32x4*)(C.w_in + (size_t)k * INC + hh * 64);
#pragma unroll
            for (int i = 0; i < 16; ++i) { const f32x4 v = src[i]; wr[4 * i] = v.x; wr[4 * i + 1] = v.y; wr[4 * i + 2] = v.z; wr[4 * i + 3] = v.w; }
#pragma unroll 1
            for (int c = cq * 32; c < cq * 32 + 32; ++c) { const float* uk = C.w_uk + (size_t)(hh * 128 + c) * 64; float acc = 0.f;
#pragma unroll
                for (int d4 = 0; d4 < 4; ++d4) {
#pragma unroll
                    for (int d = 0; d < 16; ++d) acc += wr[d4 * 16 + d] * uk[d4 * 16 + d];
                    asm volatile("" ::: "memory"); }
                C.WinT[(size_t)(hh * 128 + c) * DM + k] = (bf16)f2bf(acc * 0.125f); }
            continue; } r -= 512;
        {
            const int hh = r / 32, rem = r % 32, cblk = rem / 16, nq = rem % 16, c = cblk * 64 + lane;
            float ur[64]; const f32x4* src = (const f32x4*)(C.w_uv + (size_t)(hh * 128 + c) * 64);
#pragma unroll
            for (int i = 0; i < 16; ++i) { const f32x4 v = src[i]; ur[4 * i] = v.x; ur[4 * i + 1] = v.y; ur[4 * i + 2] = v.z; ur[4 * i + 3] = v.w; }
#pragma unroll 1
            for (int n = nq * 64; n < nq * 64 + 64; ++n) { const float* wo = C.w_out + (size_t)(hh * 64) * DM + n; float acc = 0.f;
#pragma unroll
                for (int d4 = 0; d4 < 4; ++d4) {
#pragma unroll
                    for (int d = 0; d < 16; ++d) acc += ur[d4 * 16 + d] * wo[(size_t)(d4 * 16 + d) * DM];
                    asm volatile("" ::: "memory"); }
                C.WoutT[(size_t)n * KOUT + hh * 128 + c] = (bf16)f2bf(acc); }
        }
    }
    for (int i = blockIdx.x * 512 + C.tid; i < 64 * DM; i += C.G * 512) { const int r = i >> 10, k = i & 1023; float v = 0.f;
        if (r < 8) v = C.w_in[(size_t)k * INC + 1216 + r]; else if (r < 12) v = C.w_in[(size_t)k * INC + 2760 + (r - 8)]; else if (r < 16) v = C.w_in[(size_t)k * INC + 2764 + (r - 12)];
        C.WinT[(size_t)(PC_SMALL + r) * DM + k] = (bf16)f2bf(v); }
    { f32x4 nx[4]; const int mend = MROWS * d0_;
      if (C.gw < mend) { const f32x4* xr = (const f32x4*)(C.x + (size_t)(C.gw & (MROWS - 1)) * DM) + lane;
#pragma unroll
        for (int j = 0; j < 4; ++j) nx[j] = xr[64 * j]; }
      for (int mm = C.gw; mm < mend; mm += C.NGW) { const int m = mm & (MROWS - 1); f32x4 v[4];
#pragma unroll
        for (int j = 0; j < 4; ++j) v[j] = nx[j];
        if (mm + C.NGW < mend) { const f32x4* xr = (const f32x4*)(C.x + (size_t)((mm + C.NGW) & (MROWS - 1)) * DM) + lane;
#pragma unroll
          for (int j = 0; j < 4; ++j) nx[j] = xr[64 * j]; }
        float s = 0.f;
#pragma unroll
        for (int j = 0; j < 4; ++j) s += (v[j].x * v[j].x + v[j].y * v[j].y) + (v[j].z * v[j].z + v[j].w * v[j].w);
        const float rstd = 1.0f / sqrtf(wave_sum(s) * (1.0f / DM) + EPS); const f32x4* gr = (const f32x4*)C.g_pre_mix + lane;
        unsigned long long* o8 = (unsigned long long*)(C.R1 + (size_t)m * DM) + lane;
#pragma unroll
        for (int j = 0; j < 4; ++j) { const f32x4 gg = gr[64 * j];
          o8[64 * j] = (unsigned long long)pk2(v[j].x * rstd * gg.x, v[j].y * rstd * gg.y) | ((unsigned long long)pk2(v[j].z * rstd * gg.z, v[j].w * rstd * gg.w) << 32); } } }
}

__device__ __forceinline__ void p2_cn(const Ctx& C) {
    const int lane = C.lane; const float g0 = C.c_norm[2 * lane], g1 = C.c_norm[2 * lane + 1];
    for (int mm = C.gw; mm < MROWS * (1 + ((C.dup >> 2) & 1)); mm += C.NGW) { const int m = mm & (MROWS - 1);
        const unsigned u = *(const unsigned*)(C.proj + (size_t)m * NPROJ + PC_CKV + 2 * lane); const float a = bflo(u), b = bfhi(u);
        const float r = 1.0f / sqrtf(wave_sum(a * a + b * b) * (1.0f / 128.f) + EPS);
        *(unsigned*)(C.cn + (size_t)m * 128 + 2 * lane) = pk2(a * r * g0, b * r * g1); }
}
__device__ __forceinline__ void p2_gdn_seq(const Ctx& C, int b, int h) {
    LAS float* qs = (LAS float*)C.lds; LAS float* ks = qs + 8192; LAS float* vs = ks + 8192; LAS float* ob = vs + 8192; LAS float* gl = ob + 8192; LAS float* bl = gl + 64;
    const int lane = C.lane, wave = C.wave, tid = C.tid;
    float S[128];
#pragma unroll
    for (int i = 0; i < 128; ++i) S[i] = 0.f;
    const float A = __expf(C.a_log[h]), dtb = C.dt_bias[h];
    const float on0 = C.o_norm[2 * lane], on1 = C.o_norm[2 * lane + 1];
    for (int chunk = 0; chunk < 32; ++chunk) {
        const int t0 = chunk * 64;
#pragma unroll 1
        for (int rr = 0; rr < 8; ++rr) { const int r = wave * 8 + rr, t = t0 + r;
#pragma unroll 1
            for (int X = 0; X < 3; ++X) { const int ch = X * 512 + h * 128 + 2 * lane; float a0 = 0.f, a1 = 0.f;
#pragma unroll
                for (int j = 0; j < 4; ++j) { const int tt = t - 3 + j;
                    if (tt >= 0) { const unsigned u = *(const unsigned*)(C.proj + (size_t)(b * SEQ + tt) * NPROJ + PC_QB + ch);
                        a0 += C.conv_w[j * 1536 + ch] * bflo(u); a1 += C.conv_w[j * 1536 + ch + 1] * bfhi(u); } }
                float y0 = silu_f(a0), y1 = silu_f(a1);
                if (X < 2) { const float rn = 1.0f / sqrtf(wave_sum(y0 * y0 + y1 * y1) + EPS); y0 *= rn; y1 *= rn; }
                if (X == 0) { y0 *= 0.08838834764831845f; y1 *= 0.08838834764831845f; }
                LAS float* dst = (X == 0 ? qs : X == 1 ? ks : vs) + r * 128 + 2 * lane; dst[0] = y0; dst[1] = y1; } }
        if (tid < 64) { const size_t m = (size_t)b * SEQ + t0 + tid; const float av = C.small[m * 16 + 8 + h], bv = C.small[m * 16 + 12 + h];
            gl[tid] = -A * softplus_f(av + dtb); bl[tid] = sigmoid_f(bv); }
        __syncthreads();
        if (tid < 128) {
#pragma unroll 1
            for (int t = 0; t < 64; ++t) { const float a = __expf(gl[t]), bt = bl[t]; const LAS float* kr = ks + t * 128; const LAS float* qr = qs + t * 128;
                float kS = 0.f;
#pragma unroll
                for (int d4 = 0; d4 < 8; ++d4) {
#pragma unroll
                    for (int d = 0; d < 16; ++d) kS += kr[d4 * 16 + d] * S[d4 * 16 + d];
                    asm volatile("" ::: "memory"); }
                const float dl = bt * (vs[t * 128 + tid] - a * kS); float o = 0.f;
#pragma unroll
                for (int d4 = 0; d4 < 8; ++d4) {
#pragma unroll
                    for (int d = 0; d < 16; ++d) { const int dd = d4 * 16 + d; S[dd] = a * S[dd] + kr[dd] * dl; o += qr[dd] * S[dd]; }
                    asm volatile("" ::: "memory"); }
                ob[t * 128 + tid] = o; } }
        __syncthreads();
#pragma unroll 1
        for (int rr = 0; rr < 8; ++rr) { const int r = wave * 8 + rr; const size_t m = (size_t)b * SEQ + t0 + r;
            const float o0 = ob[r * 128 + 2 * lane], o1 = ob[r * 128 + 2 * lane + 1];
            const float rstd = 1.0f / sqrtf(wave_sum(o0 * o0 + o1 * o1) * (1.0f / 128.f) + EPS);
            const unsigned zu = *(const unsigned*)(C.proj + m * NPROJ + PC_ZB + h * 128 + 2 * lane);
            *(unsigned*)(C.R1 + m * KOUT + 1024 + h * 128 + 2 * lane) = pk2(o0 * rstd * on0 * silu_f(bflo(zu)), o1 * rstd * on1 * silu_f(bfhi(zu))); }
        __syncthreads();
    }
}

__device__ __forceinline__ unsigned f2key(float f) { unsigned u = __float_as_uint(f); if (u == 0x80000000u) u = 0u; return (u & 0x80000000u) ? ~u : (u | 0x80000000u); }
__device__ __forceinline__ void p3_dsa_query(const Ctx& C, int b, int t, LAS unsigned char* wl) {
    const int lane = C.lane; const size_t m = (size_t)b * SEQ + t; const int N = ((t >> 6) + 1) << 6, ntile = N >> 6, nsel = N < 256 ? N : 256;
    LAS float* qi = (LAS float*)wl; LAS float* qa = qi + 512; LAS int* idx = (LAS int*)(qa + 1024); LAS unsigned* sc = (LAS unsigned*)(idx + 256); LAS float* pp = (LAS float*)sc;
    const bf16* prow = C.proj + m * NPROJ;
#pragma unroll
    for (int i = 0; i < 8; ++i) qi[i * 64 + lane] = bf2f(prow[PC_QIDX + i * 64 + lane]);
#pragma unroll
    for (int i = 0; i < 16; ++i) qa[i * 64 + lane] = bf2f(prow[PC_QABS + i * 64 + lane]);
    float wi[8];
#pragma unroll
    for (int hh = 0; hh < 8; ++hh) wi[hh] = C.small[m * 16 + hh] * 0.35355339059327373f;
    LDS_WAIT();
#pragma unroll 1
    for (int i = 0; i < ntile; ++i) { const int s = i * 64 + lane; const v4u* kr = (const v4u*)(C.proj + (size_t)(b * SEQ + s) * NPROJ + PC_KIDX);
        float kf[64];
#pragma unroll
        for (int j = 0; j < 8; ++j) { const v4u u = kr[j]; kf[8 * j] = bflo(u.x); kf[8 * j + 1] = bfhi(u.x); kf[8 * j + 2] = bflo(u.y); kf[8 * j + 3] = bfhi(u.y); kf[8 * j + 4] = bflo(u.z); kf[8 * j + 5] = bfhi(u.z); kf[8 * j + 6] = bflo(u.w); kf[8 * j + 7] = bfhi(u.w); }
        float score = 0.f;
#pragma unroll
        for (int hh = 0; hh < 8; ++hh) { float d = 0.f;
#pragma unroll
            for (int e = 0; e < 64; ++e) d += qi[hh * 64 + e] * kf[e];
            score += wi[hh] * fmaxf(d, 0.f); asm volatile("" ::: "memory"); }
        sc[s] = f2key(score); }
    LDS_WAIT();
    if (N <= 256) {
        for (int i = 0; i < ntile; ++i) idx[i * 64 + lane] = i * 64 + lane;
    } else {
        unsigned uk[32];
#pragma unroll
        for (int i = 0; i < 32; ++i) uk[i] = (i < ntile) ? sc[i * 64 + lane] : 0u;
        unsigned K = 0u;
#pragma unroll 1
        for (int bit = 31; bit >= 0; --bit) { const unsigned cand = K | (1u << bit); int cnt = 0;
#pragma unroll
            for (int i = 0; i < 32; ++i) if (i < ntile) cnt += __popcll(__ballot(uk[i] >= cand));
            if (cnt >= 256) K = cand; }
        int cgt = 0;
#pragma unroll
        for (int i = 0; i < 32; ++i) if (i < ntile) cgt += __popcll(__ballot(uk[i] > K));
        const int need = 256 - cgt; int base = 0, tie_seen = 0; const unsigned long long lt = (1ull << lane) - 1ull;
#pragma unroll
        for (int i = 0; i < 32; ++i) if (i < ntile) {
            const bool gt = uk[i] > K, eq = uk[i] == K; const unsigned long long mEq = __ballot(eq);
            const int rank_eq = tie_seen + __popcll(mEq & lt); const bool sel = gt || (eq && rank_eq < need);
            const unsigned long long mSel = __ballot(sel); const int pos = base + __popcll(mSel & lt);
            if (sel) idx[pos] = i * 64 + lane;
            base += __popcll(mSel); tie_seen += __popcll(mEq); }
    }
    LDS_WAIT();
#pragma unroll 1
    for (int jj = 0; jj < 4; ++jj) { const int j = jj * 64 + lane;
        if (j < nsel) { const int s = idx[j]; const v4u* cr = (const v4u*)(C.cn + (size_t)(b * SEQ + s) * 128);
            float acc[8];
#pragma unroll
            for (int hh = 0; hh < 8; ++hh) acc[hh] = 0.f;
#pragma unroll 1
            for (int cc = 0; cc < 16; ++cc) { const v4u u = cr[cc]; float cv[8]; cv[0] = bflo(u.x); cv[1] = bfhi(u.x); cv[2] = bflo(u.y); cv[3] = bfhi(u.y); cv[4] = bflo(u.z); cv[5] = bfhi(u.z); cv[6] = bflo(u.w); cv[7] = bfhi(u.w);
#pragma unroll
                for (int hh = 0; hh < 8; ++hh)
#pragma unroll
                    for (int e = 0; e < 8; ++e) acc[hh] += qa[hh * 128 + cc * 8 + e] * cv[e]; }
            const int bk = t5_bucket(s - t);
#pragma unroll
            for (int hh = 0; hh < 8; ++hh) pp[j * 8 + hh] = acc[hh] + C.rel_bias[bk * 8 + hh];
        } else {
#pragma unroll
            for (int hh = 0; hh < 8; ++hh) pp[j * 8 + hh] = -__builtin_inff();
        } }
    LDS_WAIT();
#pragma unroll
    for (int hh = 0; hh < 8; ++hh) { float v[4]; float mx = -__builtin_inff();
#pragma unroll
        for (int jj = 0; jj < 4; ++jj) { v[jj] = pp[(jj * 64 + lane) * 8 + hh]; mx = fmaxf(mx, v[jj]); }
        mx = wave_max(mx); float sm = 0.f;
#pragma unroll
        for (int jj = 0; jj < 4; ++jj) { v[jj] = __expf(v[jj] - mx); sm += v[jj]; }
        sm = 1.0f / wave_sum(sm);
#pragma unroll
        for (int jj = 0; jj < 4; ++jj) pp[(jj * 64 + lane) * 8 + hh] = v[jj] * sm; }
    LDS_WAIT();
    float o0[8], o1[8];
#pragma unroll
    for (int hh = 0; hh < 8; ++hh) { o0[hh] = 0.f; o1[hh] = 0.f; }
#pragma unroll 2
    for (int j = 0; j < nsel; ++j) { const int s = idx[j]; const unsigned u = *(const unsigned*)(C.cn + (size_t)(b * SEQ + s) * 128 + 2 * lane); const float c0 = bflo(u), c1 = bfhi(u);
        const f32x4 pa = *(const LAS f32x4*)(pp + j * 8), pb = *(const LAS f32x4*)(pp + j * 8 + 4);
        o0[0] += pa.x * c0; o1[0] += pa.x * c1; o0[1] += pa.y * c0; o1[1] += pa.y * c1; o0[2] += pa.z * c0; o1[2] += pa.z * c1; o0[3] += pa.w * c0; o1[3] += pa.w * c1;
        o0[4] += pb.x * c0; o1[4] += pb.x * c1; o0[5] += pb.y * c0; o1[5] += pb.y * c1; o0[6] += pb.z * c0; o1[6] += pb.z * c1; o0[7] += pb.w * c0; o1[7] += pb.w * c1; }
#pragma unroll
    for (int hh = 0; hh < 8; ++hh) *(unsigned*)(C.R1 + m * KOUT + hh * 128 + 2 * lane) = pk2(o0[hh], o1[hh]);
    LDS_WAIT();
}
__device__ __forceinline__ void p3_dsa(const Ctx& C) {
    LAS unsigned char* wl = C.lds + C.wave * 15360;
    for (int q = C.gw; q < MROWS; q += C.NGW) { const int b = q >> 11, t = ((q & 2047) + 128 * b) & 2047; p3_dsa_query(C, b, t, wl); }
}

__device__ __forceinline__ void p5_postnorm(const Ctx& C) {
    const int lane = C.lane, mend = MROWS * (1 + ((C.dup >> 6) & 1));
    const f32x4* g1 = (const f32x4*)C.g_post_mix + lane; const f32x4* g2 = (const f32x4*)C.g_pre_mlp + lane;
    f32x4 nm[4], nx[4];
    if (C.gw < mend) { const int m = C.gw & (MROWS - 1); const f32x4* mr = (const f32x4*)(C.mix + (size_t)m * DM) + lane; const f32x4* xr = (const f32x4*)(C.x + (size_t)m * DM) + lane;
#pragma unroll
        for (int j = 0; j < 4; ++j) { nm[j] = mr[64 * j]; nx[j] = xr[64 * j]; } }
    for (int mm = C.gw; mm < mend; mm += C.NGW) { const int m = mm & (MROWS - 1);
        f32x4 v[4], xv[4]; float s = 0.f;
#pragma unroll
        for (int j = 0; j < 4; ++j) { v[j] = nm[j]; xv[j] = nx[j]; }
        if (mm + C.NGW < mend) { const int m2 = (mm + C.NGW) & (MROWS - 1); const f32x4* mr = (const f32x4*)(C.mix + (size_t)m2 * DM) + lane; const f32x4* xr = (const f32x4*)(C.x + (size_t)m2 * DM) + lane;
#pragma unroll
            for (int j = 0; j < 4; ++j) { nm[j] = mr[64 * j]; nx[j] = xr[64 * j]; } }
#pragma unroll
        for (int j = 0; j < 4; ++j) s += (v[j].x * v[j].x + v[j].y * v[j].y) + (v[j].z * v[j].z + v[j].w * v[j].w);
        const float rstd = 1.0f / sqrtf(wave_sum(s) * (1.0f / DM) + EPS); float s2 = 0.f;
        f32x4* orow = (f32x4*)(C.out + (size_t)m * DM) + lane;
#pragma unroll
        for (int j = 0; j < 4; ++j) { v[j] = xv[j] + v[j] * rstd * g1[64 * j]; orow[64 * j] = v[j]; s2 += (v[j].x * v[j].x + v[j].y * v[j].y) + (v[j].z * v[j].z + v[j].w * v[j].w); }
        const float rstd2 = 1.0f / sqrtf(wave_sum(s2) * (1.0f / DM) + EPS);
        unsigned long long* o8 = (unsigned long long*)(C.R1 + (size_t)m * DM) + lane;
#pragma unroll
        for (int j = 0; j < 4; ++j) { const f32x4 gg = g2[64 * j];
            o8[64 * j] = (unsigned long long)pk2(v[j].x * rstd2 * gg.x, v[j].y * rstd2 * gg.y) | ((unsigned long long)pk2(v[j].z * rstd2 * gg.z, v[j].w * rstd2 * gg.w) << 32); }
    }
}
__device__ __forceinline__ void p8_final(const Ctx& C) {
    const int lane = C.lane; const f32x4* g1 = (const f32x4*)C.g_post_mlp + lane;
    f32x4 ny[4], no[4];
    if (C.gw < MROWS) { const f32x4* yr = (const f32x4*)(C.y + (size_t)C.gw * DM) + lane; const f32x4* orow = (const f32x4*)(C.out + (size_t)C.gw * DM) + lane;
#pragma unroll
        for (int j = 0; j < 4; ++j) { ny[j] = yr[64 * j]; no[j] = orow[64 * j]; } }
    for (int m = C.gw; m < MROWS; m += C.NGW) {
        f32x4 v[4], ov[4]; float s = 0.f;
#pragma unroll
        for (int j = 0; j < 4; ++j) { v[j] = ny[j]; ov[j] = no[j]; }
        if (m + C.NGW < MROWS) { const f32x4* yr = (const f32x4*)(C.y + (size_t)(m + C.NGW) * DM) + lane; const f32x4* orow2 = (const f32x4*)(C.out + (size_t)(m + C.NGW) * DM) + lane;
#pragma unroll
            for (int j = 0; j < 4; ++j) { ny[j] = yr[64 * j]; no[j] = orow2[64 * j]; } }
#pragma unroll
        for (int j = 0; j < 4; ++j) s += (v[j].x * v[j].x + v[j].y * v[j].y) + (v[j].z * v[j].z + v[j].w * v[j].w);
        const float rstd = 1.0f / sqrtf(wave_sum(s) * (1.0f / DM) + EPS);
        f32x4* orow = (f32x4*)(C.out + (size_t)m * DM) + lane;
#pragma unroll
        for (int j = 0; j < 4; ++j) orow[64 * j] = ov[j] + v[j] * rstd * g1[64 * j];
    }
}

namespace dsa {
using bf16x8 = __attribute__((ext_vector_type(8))) short;
using s16x4  = __attribute__((ext_vector_type(4))) short;
using f32x16 = __attribute__((ext_vector_type(16))) float;
using f32x4v = __attribute__((ext_vector_type(4))) float;
using u32x4  = __attribute__((ext_vector_type(4))) unsigned;
typedef unsigned long long u64;
constexpr int KVB = 16384;
constexpr int OFF_V = 0, OFF_K = 2 * KVB, OFF_WS = 4 * KVB, OFF_BIAS = OFF_WS + 8 * 256, BIAS_N = 288, BIAS_Z = 224, OFF_MASK = 132096;
constexpr float THR = 8.f;
#define KSWZ(row, colB) ((row) * 256 + ((colB) ^ (((row) & 7) << 4)))
#define SBAR() __builtin_amdgcn_sched_barrier(0)
__device__ __forceinline__ int crow(int r, int hi) { return (r & 3) + 8 * (r >> 2) + 4 * hi; }
__device__ __forceinline__ unsigned cvtpk(float lo, float hi) { unsigned r; asm volatile("v_cvt_pk_bf16_f32 %0, %1, %2" : "=v"(r) : "v"(lo), "v"(hi)); return r; }
__device__ __forceinline__ float maskf(float p, unsigned w, int c) { const int m = ((int)(w << (31 - c))) >> 31; return __uint_as_float(__float_as_uint(p) & (unsigned)m); }

__device__ __forceinline__ void partialSM(f32x16& p0, f32x16& p1, float& m_reg, float& mn, float& alpha, float badd, unsigned mlo) {
  constexpr float C = 1.4426950408889634f;
  float pmax = p0[0];
#pragma unroll
  for (int r = 1; r < 16; ++r) pmax = fmaxf(pmax, p0[r]);
#pragma unroll
  for (int r = 0; r < 16; ++r) pmax = fmaxf(pmax, p1[r]);
  { auto rr = __builtin_amdgcn_permlane32_swap(__float_as_uint(pmax), __float_as_uint(pmax), false, false);
    pmax = fmaxf(__uint_as_float(rr[0]), __uint_as_float(rr[1])); }
  pmax += badd;
  if (__builtin_expect(__all(pmax - m_reg <= THR), 1)) { mn = m_reg; alpha = 1.f; }
  else { mn = fmaxf(m_reg, pmax); alpha = __builtin_amdgcn_exp2f((m_reg - mn) * C); m_reg = mn; }
  const float mnC = (badd - mn) * C;
#pragma unroll
  for (int r = 0; r < 16; ++r) p0[r] = fmaf(p0[r], C, mnC);
#pragma unroll
  for (int r = 0; r < 16; ++r) p1[r] = fmaf(p1[r], C, mnC);
#pragma unroll
  for (int r = 0; r < 16; ++r) p0[r] = maskf(__builtin_amdgcn_exp2f(p0[r]), mlo, (r & 3) + 8 * (r >> 2));
}
__device__ __forceinline__ void finishSM(f32x16& p0, f32x16& p1, float alpha, float& l_reg, bf16x8& pa0, bf16x8& pa1, bf16x8& pa2, bf16x8& pa3, unsigned mhi) {
#pragma unroll
  for (int r = 0; r < 16; ++r) p1[r] = maskf(__builtin_amdgcn_exp2f(p1[r]), mhi, (r & 3) + 8 * (r >> 2));
  float ps = 0;
#pragma unroll
  for (int r = 0; r < 16; ++r) ps += p0[r];
#pragma unroll
  for (int r = 0; r < 16; ++r) ps += p1[r];
  { auto rr = __builtin_amdgcn_permlane32_swap(__float_as_uint(ps), __float_as_uint(ps), false, false);
    ps = __uint_as_float(rr[0]) + __uint_as_float(rr[1]); }
  l_reg = l_reg * alpha + ps;
#define PK4(P, BASE, OUT) do { unsigned a0 = cvtpk(P[BASE + 0], P[BASE + 1]), a1 = cvtpk(P[BASE + 2], P[BASE + 3]);   \
    unsigned b0 = cvtpk(P[BASE + 4], P[BASE + 5]), b1 = cvtpk(P[BASE + 6], P[BASE + 7]);                              \
    auto r0 = __builtin_amdgcn_permlane32_swap(a0, b0, false, false); auto r1 = __builtin_amdgcn_permlane32_swap(a1, b1, false, false); \
    u32x4 w = {r0[0], r1[0], r0[1], r1[1]}; OUT = *reinterpret_cast<bf16x8*>(&w); } while (0)
  PK4(p0, 0, pa0); PK4(p0, 8, pa1); PK4(p1, 0, pa2); PK4(p1, 8, pa3);
#undef PK4
}
__device__ __forceinline__ void qkt(f32x16& p0, f32x16& p1, const LAS char* Ks, const bf16x8* qr, int r32, int hi) {
  p0 = f32x16{}; p1 = f32x16{};
#pragma unroll
  for (int d0 = 0; d0 < 8; ++d0) { const int cb = (d0 * 16 + hi * 8) * 2;
    const bf16x8 b0 = *reinterpret_cast<const LAS bf16x8*>(Ks + KSWZ(r32, cb));
    const bf16x8 b1 = *reinterpret_cast<const LAS bf16x8*>(Ks + KSWZ(32 + r32, cb));
    p0 = __builtin_amdgcn_mfma_f32_32x32x16_bf16(b0, qr[d0], p0, 0, 0, 0);
    p1 = __builtin_amdgcn_mfma_f32_32x32x16_bf16(b1, qr[d0], p1, 0, 0, 0); }
}
__device__ __forceinline__ int v_st(int k, int c) { const int kk = (k & ~0xC) | ((k & 4) << 1) | ((k & 8) >> 1); return ((kk >> 3) * 4 + (c >> 5)) * 512 + ((kk & 7) * 32 + (c & 31)) * 2; }
__device__ __forceinline__ int v_rd_base(int lane) { return ((lane & 3) << 3) | (((lane >> 2) & 3) << 6) | (((lane >> 4) & 1) << 5) | (((lane >> 5) & 1) << 8); }
constexpr int v_rd_off(int d0, int ks, int half) { return d0 * 512 + ks * 4096 + half * 2048; }
template <int OFF> __device__ __forceinline__ s16x4 tr_read(int vb) {
  s16x4 r; asm volatile("ds_read_b64_tr_b16 %0, %1 offset:%2" : "=&v"(r) : "v"(vb), "i"(OFF) : "memory"); return r;
}
template <int D0> __device__ __forceinline__ void pv_one(f32x16& od, int vb, bf16x8 pa0, bf16x8 pa1, bf16x8 pa2, bf16x8 pa3) {
  const s16x4 l0 = tr_read<v_rd_off(D0, 0, 0)>(vb), h0 = tr_read<v_rd_off(D0, 0, 1)>(vb), l1 = tr_read<v_rd_off(D0, 1, 0)>(vb), h1 = tr_read<v_rd_off(D0, 1, 1)>(vb);
  const s16x4 l2 = tr_read<v_rd_off(D0, 2, 0)>(vb), h2 = tr_read<v_rd_off(D0, 2, 1)>(vb), l3 = tr_read<v_rd_off(D0, 3, 0)>(vb), h3 = tr_read<v_rd_off(D0, 3, 1)>(vb);
  asm volatile("s_waitcnt lgkmcnt(0)" ::: "memory"); SBAR();
#define PK(L, H) (bf16x8){L[0], L[1], L[2], L[3], H[0], H[1], H[2], H[3]}
  od = __builtin_amdgcn_mfma_f32_32x32x16_bf16(pa0, PK(l0, h0), od, 0, 0, 0);
  od = __builtin_amdgcn_mfma_f32_32x32x16_bf16(pa1, PK(l1, h1), od, 0, 0, 0);
  od = __builtin_amdgcn_mfma_f32_32x32x16_bf16(pa2, PK(l2, h2), od, 0, 0, 0);
  od = __builtin_amdgcn_mfma_f32_32x32x16_bf16(pa3, PK(l3, h3), od, 0, 0, 0);
#undef PK
}
__device__ __forceinline__ void pv_d0(f32x16* o, int vb, bf16x8 pa0, bf16x8 pa1, bf16x8 pa2, bf16x8 pa3) {
  pv_one<0>(o[0], vb, pa0, pa1, pa2, pa3); pv_one<1>(o[1], vb, pa0, pa1, pa2, pa3); pv_one<2>(o[2], vb, pa0, pa1, pa2, pa3); pv_one<3>(o[3], vb, pa0, pa1, pa2, pa3);
}

__device__ __forceinline__ void attn_item(const Ctx& C, int b, int q0, int N) {
  const int tid = C.tid, wid = C.wave, lane = C.lane, r32 = lane & 31, hi = lane >> 5;
  const int NT = N >> 6;
  LAS char* V_lds = (LAS char*)C.lds + OFF_V; LAS char* K_lds = (LAS char*)C.lds + OFF_K;
  LAS float* wsp = (LAS float*)(C.lds + OFF_WS) + wid * 64; LAS float* li_l = wsp; LAS float* al_l = wsp + 32;
  const LAS float* btab = (const LAS float*)(C.lds + OFF_BIAS) + wid * BIAS_N;
  const LAS u64* mrow = (const LAS u64*)(C.lds + OFF_MASK) + r32 * 32;
  const float b15 = C.rel_bias[15 * 8 + wid];
  float m_reg = -1e30f, l_reg = 0.f; f32x16 o[4] = {}; bf16x8 qr[8];
  const bf16* Qw = C.proj + (size_t)(b * SEQ + q0 + r32) * NPROJ + PC_QABS + wid * 128 + hi * 8;
#pragma unroll
  for (int d0 = 0; d0 < 8; ++d0) qr[d0] = *reinterpret_cast<const bf16x8*>(Qw + d0 * 16);
  const int sr = tid >> 4, sc = (tid & 15) * 8, vst0 = v_st(sr, sc), vst1 = v_st(32 + sr, sc), kst0 = KSWZ(sr, sc * 2), kst1 = KSWZ(32 + sr, sc * 2);
  const int vb0 = (int)(unsigned)(size_t)V_lds + v_rd_base(lane);
  const bf16* Cb = C.cn + (size_t)b * SEQ * 128 + sc;
  bf16x8 sA0, sA1;
#define SLOAD(S0, S1, k0) do { S0 = *reinterpret_cast<const bf16x8*>(Cb + (size_t)((k0) + sr) * 128); S1 = *reinterpret_cast<const bf16x8*>(Cb + (size_t)((k0) + 32 + sr) * 128); } while (0)
#define SWRITE(bf, S0, S1) do { *reinterpret_cast<LAS bf16x8*>(V_lds + (bf) * KVB + vst0) = S0; *reinterpret_cast<LAS bf16x8*>(V_lds + (bf) * KVB + vst1) = S1; \
    *reinterpret_cast<LAS bf16x8*>(K_lds + (bf) * KVB + kst0) = S0; *reinterpret_cast<LAS bf16x8*>(K_lds + (bf) * KVB + kst1) = S1; } while (0)
#define SWAIT() asm volatile("s_waitcnt vmcnt(2)" ::: "memory")
#define RESC(a) do { if (__any((a) < 1.f)) { if (hi == 0) al_l[r32] = (a); asm volatile("s_waitcnt lgkmcnt(0)" ::: "memory"); \
    _Pragma("unroll") for (int d = 0; d < 4; ++d) _Pragma("unroll") for (int r = 0; r < 16; ++r) o[d][r] *= al_l[crow(r, hi)]; } } while (0)
#define SCORE(P0, P1, bf, jt, BADD, MW) do { qkt(P0, P1, K_lds + (bf) * KVB, qr, r32, hi); MW = mrow[(jt)]; \
    if ((jt) < NT && 64 * (jt) + 63 - q0 > -128) { const LAS float* tb = btab + (64 * (jt) - q0 - r32 + BIAS_Z + 4 * hi); BADD = 0.f; \
      _Pragma("unroll") for (int r = 0; r < 16; ++r) { const int c = (r & 3) + 8 * (r >> 2); P0[r] += tb[c]; P1[r] += tb[32 + c]; } } \
    else BADD = b15; } while (0)
#define MLO(MW) (((unsigned)(MW)) >> (4 * hi))
#define MHI(MW) (((unsigned)((MW) >> 32)) >> (4 * hi))
  f32x16 pA0, pA1; float mnA, alA, bdA; u64 mwA; bf16x8 pa0, pa1, pa2, pa3;
  SLOAD(sA0, sA1, 0); asm volatile("s_waitcnt vmcnt(0)" ::: "memory"); SWRITE(0, sA0, sA1); __syncthreads();
  if (1 < NT) SLOAD(sA0, sA1, 64);
#pragma unroll 1
  for (int jt = 0; jt < NT; ++jt) { const int cur = jt & 1;
    SBAR(); SCORE(pA0, pA1, cur, jt, bdA, mwA);
    partialSM(pA0, pA1, m_reg, mnA, alA, bdA, MLO(mwA));
    RESC(alA);
    finishSM(pA0, pA1, alA, l_reg, pa0, pa1, pa2, pa3, MHI(mwA)); SBAR();
    pv_d0(o, vb0 + cur * KVB, pa0, pa1, pa2, pa3);
    if (jt + 1 < NT) { SWRITE(cur ^ 1, sA0, sA1); if (jt + 2 < NT) SLOAD(sA0, sA1, (jt + 2) * 64); }
    __syncthreads();
  }
  if (hi == 0) li_l[r32] = l_reg; asm volatile("s_waitcnt lgkmcnt(0)" ::: "memory");
  float rli[16];
#pragma unroll
  for (int r = 0; r < 16; ++r) rli[r] = __builtin_amdgcn_rcpf(li_l[crow(r, hi)]);
  bf16* Ow = C.R1 + (size_t)(b * SEQ + q0) * KOUT + wid * 128;
#pragma unroll
  for (int r = 0; r < 16; ++r) { const int orow = crow(r, hi);
#pragma unroll
    for (int d0 = 0; d0 < 4; ++d0) Ow[(size_t)orow * KOUT + d0 * 32 + r32] = (bf16)f2bf(o[d0][r] * rli[r]); }
#undef SLOAD
#undef SWRITE
#undef SWAIT
#undef RESC
#undef SCORE
#undef MLO
#undef MHI
}

__device__ __forceinline__ void scores16(const Ctx& C, int b, int q0g, int N) {
  const int lane = C.lane, lq = lane & 15, g = lane >> 4, wave = C.wave;
  LAS float* sc = (LAS float*)C.lds;
  const bf16* prow = C.proj + (size_t)(b * SEQ + q0g + lq) * NPROJ + PC_QIDX + g * 8;
  bf16x8 bq[8][2]; float wv[8];
#pragma unroll
  for (int hh = 0; hh < 8; ++hh) { bq[hh][0] = *reinterpret_cast<const bf16x8*>(prow + hh * 64); bq[hh][1] = *reinterpret_cast<const bf16x8*>(prow + hh * 64 + 32);
    wv[hh] = C.small[(size_t)(b * SEQ + q0g + lq) * 16 + hh] * 0.35355339059327373f; }
  const int nt16 = N >> 4;
  const bf16* kbase = C.proj + (size_t)(b * SEQ + lq) * NPROJ + PC_KIDX + g * 8;
  bf16x8 a0, a1, n0, n1;
  if (wave < nt16) { const bf16* kr = kbase + (size_t)(16 * wave) * NPROJ; n0 = *reinterpret_cast<const bf16x8*>(kr); n1 = *reinterpret_cast<const bf16x8*>(kr + 32); }
  for (int j = wave; j < nt16; j += 8) {
    a0 = n0; a1 = n1;
    if (j + 8 < nt16) { const bf16* kr = kbase + (size_t)(16 * (j + 8)) * NPROJ; n0 = *reinterpret_cast<const bf16x8*>(kr); n1 = *reinterpret_cast<const bf16x8*>(kr + 32); }
    f32x4v acc[8];
#pragma unroll
    for (int hh = 0; hh < 8; ++hh) acc[hh] = __builtin_amdgcn_mfma_f32_16x16x32_bf16(a0, bq[hh][0], (f32x4v){0.f, 0.f, 0.f, 0.f}, 0, 0, 0);
#pragma unroll
    for (int hh = 0; hh < 8; ++hh) acc[hh] = __builtin_amdgcn_mfma_f32_16x16x32_bf16(a1, bq[hh][1], acc[hh], 0, 0, 0);
    f32x4v s4 = {0.f, 0.f, 0.f, 0.f};
#pragma unroll
    for (int hh = 0; hh < 8; ++hh)
#pragma unroll
      for (int r = 0; r < 4; ++r) s4[r] += wv[hh] * fmaxf(acc[hh][r], 0.f);
    *reinterpret_cast<LAS f32x4v*>(sc + lq * (N + 4) + 16 * j + 4 * g) = s4;
  }
}
__device__ __forceinline__ void select16(const Ctx& C, int grp, int N) {
  const int lane = C.lane, NT = N >> 6;
  const LAS float* sc = (const LAS float*)C.lds; LAS u64* mask = (LAS u64*)(C.lds + OFF_MASK);
#pragma unroll 1
  for (int qq = 2 * C.wave; qq < 2 * C.wave + 2; ++qq) {
    const LAS float* row = sc + qq * (N + 4);
    unsigned uk[32];
#pragma unroll
    for (int i = 0; i < 32; ++i) uk[i] = (i < NT) ? f2key(row[i * 64 + lane]) : 0u;
    unsigned K = 0u; bool exact = false;
#pragma unroll 1
    for (int bit = 31; bit >= 0; --bit) { const unsigned cand = K | (1u << bit); int cnt = 0;
#pragma unroll
      for (int i = 0; i < 32; ++i) if (i < NT) cnt += __popcll(__ballot(uk[i] >= cand));
      if (cnt >= 256) { K = cand; if (cnt == 256) { exact = true; break; } } }
    LAS u64* mq = mask + (grp * 16 + qq) * 32;
    if (exact) {
#pragma unroll
      for (int i = 0; i < 32; ++i) if (i < NT) { const u64 m = __ballot(uk[i] >= K); if (lane == 0) mq[i] = m; }
    } else {
      int cgt = 0;
#pragma unroll
      for (int i = 0; i < 32; ++i) if (i < NT) cgt += __popcll(__ballot(uk[i] > K));
      const int need = 256 - cgt; int tie_seen = 0; const u64 lt = (1ull << lane) - 1ull;
#pragma unroll
      for (int i = 0; i < 32; ++i) if (i < NT) {
        const bool gt = uk[i] > K, eq = uk[i] == K; const u64 mEq = __ballot(eq);
        const int rank_eq = tie_seen + __popcll(mEq & lt); const bool sel = gt || (eq && rank_eq < need);
        const u64 m = __ballot(sel); if (lane == 0) mq[i] = m;
        tie_seen += __popcll(mEq); }
    }
    if (lane == 0 && NT < 32) mq[NT] = 0ull;
  }
}
__device__ __forceinline__ void dsa_item(const Ctx& C, int b, int qb) {
  const int q0 = qb * 32, N = ((qb >> 1) + 1) * 64, NT = N >> 6, tid = C.tid;
  LAS u64* mask = (LAS u64*)(C.lds + OFF_MASK);
  if (N <= 256) {
    for (int i = tid; i < 32 * 32; i += 512) mask[i] = ((i & 31) < NT) ? ~0ull : 0ull;
  } else {
#pragma unroll 1
    for (int grp = 0; grp < 2; ++grp) { scores16(C, b, q0 + 16 * grp, N); __syncthreads(); select16(C, grp, N); __syncthreads(); }
  }
  { LAS float* bt = (LAS float*)(C.lds + OFF_BIAS);
    for (int i = tid; i < 8 * BIAS_N; i += 512) { const int hh = i / BIAS_N, e = i % BIAS_N; bt[i] = C.rel_bias[t5_bucket(e - BIAS_Z) * 8 + hh]; } }
  __syncthreads();
  attn_item(C, b, q0, N);
  __syncthreads();
}
__device__ __forceinline__ void p3_dsa_mfma(const Ctx& C) {
  for (int pq = blockIdx.x; pq < 512 * (1 + ((C.dup >> 4) & 1)); pq += C.G) { const int pi = pq & 511, b = pi >> 5, pr = pi & 31;
    dsa_item(C, b, 63 - pr); dsa_item(C, b, pr); }
}
#undef KSWZ
#undef SBAR
}
namespace gdn {
using bf16x8 = __attribute__((ext_vector_type(8))) short;
using f32x16 = __attribute__((ext_vector_type(16))) float;
using f32x4v = __attribute__((ext_vector_type(4))) float;
using u32x4  = __attribute__((ext_vector_type(4))) unsigned;
using u32x2  = __attribute__((ext_vector_type(2))) unsigned;
typedef __bf16 bf2 __attribute__((ext_vector_type(2)));
typedef float fl2 __attribute__((ext_vector_type(2)));
__device__ __forceinline__ unsigned pkbf(float lo, float hi) { fl2 v = {lo, hi}; return __builtin_bit_cast(unsigned, __builtin_convertvector(v, bf2)); }
__device__ __forceinline__ int crow(int r, int hi) { return (r & 3) + 8 * (r >> 2) + 4 * hi; }
constexpr int LDF = 132, LDB = 136, LDL = 68;
constexpr int OFF_KF = 0, OFF_VF = 33792, OFF_KB = 67584, OFF_QB = 84992, OFF_LM = 102400, OFF_IN = 119808, OFF_GT = 137216;
constexpr size_t OPB = 57344, OP_W = 0, OP_QG = 16384, OP_KG = 32768, OP_IN = 49152, UB = 16384;

#define FNMA(acc, a, b) asm("v_fma_f32 %0, -%1, %2, %0" : "+v"(acc) : "v"(a), "v"(b))
__device__ __forceinline__ void g1_item(const Ctx& C, int item) {
  const int b = item >> 7, h = (item >> 5) & 3, c = item & 31, tid = C.tid, lane = C.lane, wave = C.wave, t0 = c * 64;
  unsigned lb0 = (unsigned)(size_t)C.lds, lb1 = (unsigned)(size_t)C.lds + OFF_LM;
  asm volatile("" : "+v"(lb0)); asm volatile("" : "+v"(lb1));
  LAS float* KF = (LAS float*)(size_t)(lb0 + OFF_KF); LAS float* VF = (LAS float*)(size_t)(lb0 + OFF_VF);
  LAS unsigned short* KB = (LAS unsigned short*)(size_t)(lb1 + (OFF_KB - OFF_LM)); LAS unsigned short* QB = (LAS unsigned short*)(size_t)(lb1 + (OFF_QB - OFF_LM));
  LAS float* LM = (LAS float*)(size_t)(lb1); LAS float* IN = (LAS float*)(size_t)(lb1 + (OFF_IN - OFF_LM));
  LAS float* gc = (LAS float*)(size_t)(lb1 + (OFF_GT - OFF_LM)); LAS float* be = gc + 64; LAS float* eg = be + 64; LAS float* ekl = eg + 64;
  unsigned char* gop = C.gop + (size_t)item * OPB; unsigned char* gu = C.gU + (size_t)item * UB;
  if (wave == 0) { const size_t m = (size_t)b * SEQ + t0 + lane; const float av = C.small[m * 16 + 8 + h], bv = C.small[m * 16 + 12 + h];
    float g = -__expf(C.a_log[h]) * softplus_f(av + C.dt_bias[h]);
#pragma unroll
    for (int o = 1; o < 64; o <<= 1) { const float t = __shfl_up(g, o); if (lane >= o) g += t; }
    const float gl = __shfl(g, 63);
    gc[lane] = g; be[lane] = sigmoid_f(bv); eg[lane] = __expf(g); ekl[lane] = __expf(gl - g);
    if (lane == 63) C.galast[item] = __expf(g); }
  { unsigned raw[3][11]; float cw[3][4][2];
#pragma unroll
    for (int X = 0; X < 3; ++X) { const int ch = X * 512 + h * 128 + 2 * lane;
#pragma unroll
      for (int j = 0; j < 11; ++j) { const int tt = t0 + wave * 8 - 3 + j; raw[X][j] = (tt >= 0) ? *(const unsigned*)(C.proj + (size_t)(b * SEQ + tt) * NPROJ + PC_QB + ch) : 0u; }
#pragma unroll
      for (int j = 0; j < 4; ++j) { const fl2 w2 = *reinterpret_cast<const fl2*>(C.conv_w + j * 1536 + ch); cw[X][j][0] = w2.x; cw[X][j][1] = w2.y; } }
#pragma unroll
    for (int rr = 0; rr < 8; ++rr) { const int r = wave * 8 + rr;
#pragma unroll
      for (int X = 0; X < 3; ++X) { float a0 = 0.f, a1 = 0.f;
#pragma unroll
        for (int j = 0; j < 4; ++j) { const unsigned u = raw[X][rr + j]; a0 += cw[X][j][0] * bflo(u); a1 += cw[X][j][1] * bfhi(u); }
        float y0 = silu_f(a0), y1 = silu_f(a1);
        if (X < 2) { const float rn = 1.0f / sqrtf(wave_sum(y0 * y0 + y1 * y1) + EPS); y0 *= rn; y1 *= rn; }
        if (X == 0) { *(LAS unsigned*)(QB + r * LDB + 2 * lane) = pkbf(y0 * 0.08838834764831845f, y1 * 0.08838834764831845f); }
        else if (X == 1) { KF[r * LDF + 2 * lane] = y0; KF[r * LDF + 2 * lane + 1] = y1; *(LAS unsigned*)(KB + r * LDB + 2 * lane) = pkbf(y0, y1); }
        else { VF[r * LDF + 2 * lane] = y0; VF[r * LDF + 2 * lane + 1] = y1; } } } }
  __syncthreads();
  { const int p = wave >> 2, tr = wave & 3, lr = lane & 15, g4 = lane >> 4; const LAS unsigned short* As = p ? QB : KB;
    bf16x8 af[4];
#pragma unroll
    for (int ks = 0; ks < 4; ++ks) af[ks] = *reinterpret_cast<const LAS bf16x8*>(As + (16 * tr + lr) * LDB + 32 * ks + 8 * g4);
    const int tcmax = (tr | 1);
#pragma unroll 1
    for (int tc = 0; tc <= tcmax; ++tc) { f32x4v acc = {0.f, 0.f, 0.f, 0.f};
#pragma unroll
      for (int ks = 0; ks < 4; ++ks) { const bf16x8 bfr = *reinterpret_cast<const LAS bf16x8*>(KB + (16 * tc + lr) * LDB + 32 * ks + 8 * g4);
        acc = __builtin_amdgcn_mfma_f32_16x16x32_bf16(af[ks], bfr, acc, 0, 0, 0); }
      const int j = 16 * tc + lr; const float gj = gc[j];
#pragma unroll
      for (int r = 0; r < 4; ++r) { const int i = 16 * tr + 4 * g4 + r; const float d = __expf(fminf(gc[i] - gj, 0.f));
        if (p == 0) LM[i * LDL + j] = (j < i) ? be[i] * acc[r] * d : 0.f; else IN[i * LDL + j] = (j <= i) ? acc[r] * d : 0.f; } } }
  __syncthreads();
  float X[64];
  if (wave < 4) {
    const int ch = (wave & 1) * 64 + lane; const bool isV = wave < 2; const LAS float* src = (isV ? VF : KF) + ch;
#pragma unroll
    for (int i = 0; i < 64; ++i) { const float sc = isV ? be[i] : be[i] * eg[i]; X[i] = src[i * LDF] * sc; if ((i & 7) == 7) asm volatile("" ::: "memory"); }
#pragma unroll
    for (int i = 1; i < 64; ++i) { float acc = X[i]; const LAS float* Lr = LM + i * LDL;
#pragma unroll
      for (int q = 0; q < (i + 3) / 4; ++q) { const f32x4v l4 = *reinterpret_cast<const LAS f32x4v*>(Lr + 4 * q);
        if (4 * q + 0 < i) FNMA(acc, l4.x, X[4 * q + 0]); if (4 * q + 1 < i) FNMA(acc, l4.y, X[4 * q + 1]); if (4 * q + 2 < i) FNMA(acc, l4.z, X[4 * q + 2]); if (4 * q + 3 < i) FNMA(acc, l4.w, X[4 * q + 3]); }
      X[i] = acc; if (i & 1) asm volatile("" ::: "memory"); }
  } else {
    const int tq = tid - 256;
#pragma unroll 1
    for (int e = tq; e < 1024; e += 256) { const int f = e >> 6, l2 = e & 63, mt = f >> 3, kb = (f >> 1) & 3, s = f & 1, m = l2 & 31, h2 = l2 >> 5, t = 32 * mt + m, dk0 = 32 * kb + 16 * s + 4 * h2;
      const u32x2 a = *reinterpret_cast<const LAS u32x2*>(QB + t * LDB + dk0), bq = *reinterpret_cast<const LAS u32x2*>(QB + t * LDB + dk0 + 8); const float sc = eg[t];
      u32x4 o; o.x = pkbf(bflo(a.x) * sc, bfhi(a.x) * sc); o.y = pkbf(bflo(a.y) * sc, bfhi(a.y) * sc); o.z = pkbf(bflo(bq.x) * sc, bfhi(bq.x) * sc); o.w = pkbf(bflo(bq.y) * sc, bfhi(bq.y) * sc);
      *reinterpret_cast<u32x4*>(gop + OP_QG + (size_t)e * 16) = o; }
#pragma unroll 1
    for (int e = tq; e < 1024; e += 256) { const int f = e >> 6, l2 = e & 63, kbm = f >> 2, tb = (f >> 1) & 1, s = f & 1, m = l2 & 31, h2 = l2 >> 5, dk = 32 * kbm + m, tp0 = 32 * tb + 16 * s + 4 * h2;
      float v[8];
#pragma unroll
      for (int jj = 0; jj < 4; ++jj) { v[jj] = KF[(tp0 + jj) * LDF + dk] * ekl[tp0 + jj]; v[4 + jj] = KF[(tp0 + 8 + jj) * LDF + dk] * ekl[tp0 + 8 + jj]; }
      u32x4 o; o.x = pkbf(v[0], v[1]); o.y = pkbf(v[2], v[3]); o.z = pkbf(v[4], v[5]); o.w = pkbf(v[6], v[7]);
      *reinterpret_cast<u32x4*>(gop + OP_KG + (size_t)e * 16) = o; }
#pragma unroll 1
    for (int e = tq; e < 512; e += 256) { const int f = e >> 6, l2 = e & 63, mt = f >> 2, tb = (f >> 1) & 1, s = f & 1, m = l2 & 31, h2 = l2 >> 5, t = 32 * mt + m, tp0 = 32 * tb + 16 * s + 4 * h2;
      const f32x4v a = *reinterpret_cast<const LAS f32x4v*>(IN + t * LDL + tp0), bq = *reinterpret_cast<const LAS f32x4v*>(IN + t * LDL + tp0 + 8);
      u32x4 o; o.x = pkbf(a.x, a.y); o.y = pkbf(a.z, a.w); o.z = pkbf(bq.x, bq.y); o.w = pkbf(bq.z, bq.w);
      *reinterpret_cast<u32x4*>(gop + OP_IN + (size_t)e * 16) = o; }
  }
  __syncthreads();
  if (wave < 2) { const int dv = wave * 64 + lane, slice = dv >> 5, n = dv & 31;
#pragma unroll
    for (int tb = 0; tb < 2; ++tb)
#pragma unroll
      for (int h2 = 0; h2 < 2; ++h2) { u32x4 o0, o1;
        o0.x = pkbf(X[32 * tb + crow(0, h2)], X[32 * tb + crow(1, h2)]); o0.y = pkbf(X[32 * tb + crow(2, h2)], X[32 * tb + crow(3, h2)]);
        o0.z = pkbf(X[32 * tb + crow(4, h2)], X[32 * tb + crow(5, h2)]); o0.w = pkbf(X[32 * tb + crow(6, h2)], X[32 * tb + crow(7, h2)]);
        o1.x = pkbf(X[32 * tb + crow(8, h2)], X[32 * tb + crow(9, h2)]); o1.y = pkbf(X[32 * tb + crow(10, h2)], X[32 * tb + crow(11, h2)]);
        o1.z = pkbf(X[32 * tb + crow(12, h2)], X[32 * tb + crow(13, h2)]); o1.w = pkbf(X[32 * tb + crow(14, h2)], X[32 * tb + crow(15, h2)]);
        u32x4* dst = reinterpret_cast<u32x4*>(gu + (size_t)((slice * 2 + tb) * 64 + (h2 * 32 + n)) * 32); dst[0] = o0; dst[1] = o1; }
  } else if (wave < 4) { const int dk = (wave & 1) * 64 + lane;
#pragma unroll
    for (int i = 0; i < 64; ++i) VF[i * LDF + dk] = X[i]; }
  __syncthreads();
#pragma unroll 1
  for (int e = tid; e < 1024; e += 512) { const int f = e >> 6, l2 = e & 63, mt = f >> 3, kb = (f >> 1) & 3, s = f & 1, m = l2 & 31, h2 = l2 >> 5, t = 32 * mt + m, dk0 = 32 * kb + 16 * s + 4 * h2;
    const f32x4v a = *reinterpret_cast<const LAS f32x4v*>(VF + t * LDF + dk0), bq = *reinterpret_cast<const LAS f32x4v*>(VF + t * LDF + dk0 + 8);
    u32x4 o; o.x = pkbf(a.x, a.y); o.y = pkbf(a.z, a.w); o.z = pkbf(bq.x, bq.y); o.w = pkbf(bq.z, bq.w);
    *reinterpret_cast<u32x4*>(gop + OP_W + (size_t)e * 16) = o; }
  __syncthreads();
}
__device__ __forceinline__ void g1_phase(const Ctx& C) {
  for (int it = blockIdx.x; it < 2048 * (1 + ((C.dup >> 2) & 1)); it += C.G) g1_item(C, it & 2047);
}

__device__ __forceinline__ bf16x8 pack8(const f32x16& x, int s) {
  u32x4 w; w.x = pkbf(x[8 * s + 0], x[8 * s + 1]); w.y = pkbf(x[8 * s + 2], x[8 * s + 3]); w.z = pkbf(x[8 * s + 4], x[8 * s + 5]); w.w = pkbf(x[8 * s + 6], x[8 * s + 7]);
  return __builtin_bit_cast(bf16x8, w);
}
#define GMFMA(a, b, c) __builtin_amdgcn_mfma_f32_32x32x16_bf16((a), (b), (c), 0, 0, 0)
__device__ __forceinline__ void g2_scan(const Ctx& C, int bh, int slice) {
  if (C.wave != 0) return;
  const int lane = C.lane, n = lane & 31, hh = lane >> 5, b = bh >> 2, h = bh & 3;
  constexpr int BUFB = 61440;
  const unsigned char* op0 = C.gop + (size_t)(bh * 32) * OPB + lane * 16; const unsigned char* u0 = C.gU + (size_t)(bh * 32) * UB + slice * 4096 + lane * 16;
#define G2_DMA(cc, bb) do { const unsigned char* _o = op0 + (size_t)(cc) * OPB; const unsigned char* _u = u0 + (size_t)(cc) * UB; LAS unsigned char* _d = C.lds + (bb) * BUFB; \
    _Pragma("unroll") for (int f = 0; f < 56; ++f) __builtin_amdgcn_global_load_lds((const unsigned*)(_o + f * 1024), (LAS unsigned*)(_d + f * 1024), 16, 0, 0); \
    _Pragma("unroll") for (int f = 0; f < 4; ++f) __builtin_amdgcn_global_load_lds((const unsigned*)(_u + f * 1024), (LAS unsigned*)(_d + 57344 + f * 1024), 16, 0, 0); } while (0)
  f32x16 S[4];
#pragma unroll
  for (int kb = 0; kb < 4; ++kb) S[kb] = f32x16{};
  G2_DMA(0, 0);
  float* og = C.og + (size_t)(b * SEQ) * 512 + h * 128 + slice * 32 + n;
  const int cmax = 32 * (1 + ((C.dup >> 3) & 1));
#pragma unroll 1
  for (int cq = 0; cq < cmax; ++cq) { const int c = cq & 31;
    asm volatile("s_waitcnt vmcnt(0)" ::: "memory");
    if (cq + 1 < cmax) G2_DMA((cq + 1) & 31, (cq + 1) & 1);
    if (c == 0) {
#pragma unroll
      for (int kb = 0; kb < 4; ++kb) S[kb] = f32x16{}; }
    const LAS unsigned char* cur = C.lds + (cq & 1) * BUFB + lane * 16;
    const float al = C.galast[bh * 32 + c];
    bf16x8 Sb[4][2];
#pragma unroll
    for (int kb = 0; kb < 4; ++kb) { Sb[kb][0] = pack8(S[kb], 0); Sb[kb][1] = pack8(S[kb], 1); }
    f32x16 P[2], O[2];
#pragma unroll
    for (int mt = 0; mt < 2; ++mt) { P[mt] = f32x16{}; O[mt] = f32x16{};
#pragma unroll
      for (int kb = 0; kb < 4; ++kb)
#pragma unroll
        for (int s = 0; s < 2; ++s) { const int f = (mt * 4 + kb) * 2 + s;
          const bf16x8 aw = *reinterpret_cast<const LAS bf16x8*>(cur + OP_W + f * 1024), aq = *reinterpret_cast<const LAS bf16x8*>(cur + OP_QG + f * 1024);
          P[mt] = GMFMA(aw, Sb[kb][s], P[mt]); O[mt] = GMFMA(aq, Sb[kb][s], O[mt]); } }
#pragma unroll
    for (int mt = 0; mt < 2; ++mt) { const LAS unsigned char* up = C.lds + (cq & 1) * BUFB + 57344 + (mt * 64 + lane) * 32;
      const u32x4 ua = *reinterpret_cast<const LAS u32x4*>(up), ub = *reinterpret_cast<const LAS u32x4*>(up + 16);
      P[mt][0] = bflo(ua.x) - P[mt][0]; P[mt][1] = bfhi(ua.x) - P[mt][1]; P[mt][2] = bflo(ua.y) - P[mt][2]; P[mt][3] = bfhi(ua.y) - P[mt][3];
      P[mt][4] = bflo(ua.z) - P[mt][4]; P[mt][5] = bfhi(ua.z) - P[mt][5]; P[mt][6] = bflo(ua.w) - P[mt][6]; P[mt][7] = bfhi(ua.w) - P[mt][7];
      P[mt][8] = bflo(ub.x) - P[mt][8]; P[mt][9] = bfhi(ub.x) - P[mt][9]; P[mt][10] = bflo(ub.y) - P[mt][10]; P[mt][11] = bfhi(ub.y) - P[mt][11];
      P[mt][12] = bflo(ub.z) - P[mt][12]; P[mt][13] = bfhi(ub.z) - P[mt][13]; P[mt][14] = bflo(ub.w) - P[mt][14]; P[mt][15] = bfhi(ub.w) - P[mt][15]; }
    bf16x8 Vb[2][2];
#pragma unroll
    for (int tb = 0; tb < 2; ++tb) { Vb[tb][0] = pack8(P[tb], 0); Vb[tb][1] = pack8(P[tb], 1); }
#pragma unroll
    for (int mt = 0; mt < 2; ++mt) {
#pragma unroll
      for (int tb = 0; tb <= mt; ++tb)
#pragma unroll
        for (int s = 0; s < 2; ++s) { const int f = (mt * 2 + tb) * 2 + s; const bf16x8 ai = *reinterpret_cast<const LAS bf16x8*>(cur + OP_IN + f * 1024); O[mt] = GMFMA(ai, Vb[tb][s], O[mt]); }
#pragma unroll
      for (int r = 0; r < 16; ++r) og[(size_t)(64 * c + 32 * mt + crow(r, hh)) * 512] = O[mt][r]; }
#pragma unroll
    for (int kb = 0; kb < 4; ++kb) {
#pragma unroll
      for (int r = 0; r < 16; ++r) S[kb][r] *= al;
#pragma unroll
      for (int tb = 0; tb < 2; ++tb)
#pragma unroll
        for (int s = 0; s < 2; ++s) { const int f = (kb * 2 + tb) * 2 + s; const bf16x8 ak = *reinterpret_cast<const LAS bf16x8*>(cur + OP_KG + f * 1024); S[kb] = GMFMA(ak, Vb[tb][s], S[kb]); } }
  }
  asm volatile("s_waitcnt vmcnt(0)" ::: "memory");
#undef G2_DMA
}
#undef GMFMA
__device__ __forceinline__ void gnorm_phase(const Ctx& C) {
  const int lane = C.lane; const float on0 = C.o_norm[2 * lane], on1 = C.o_norm[2 * lane + 1];
  for (int mm = C.gw; mm < MROWS * (1 + ((C.dup >> 4) & 1)); mm += C.NGW) { const int m = mm & (MROWS - 1);
#pragma unroll
    for (int h = 0; h < 4; ++h) { const fl2 o = *reinterpret_cast<const fl2*>(C.og + (size_t)m * 512 + h * 128 + 2 * lane);
      const float rstd = 1.0f / sqrtf(wave_sum(o.x * o.x + o.y * o.y) * (1.0f / 128.f) + EPS);
      const unsigned zu = *(const unsigned*)(C.proj + (size_t)m * NPROJ + PC_ZB + h * 128 + 2 * lane);
      *(unsigned*)(C.R1 + (size_t)m * KOUT + 1024 + h * 128 + 2 * lane) = pk2(o.x * rstd * on0 * silu_f(bflo(zu)), o.y * rstd * on1 * silu_f(bfhi(zu))); } }
}
}
__global__ void __launch_bounds__(512, 2) fwd(Args a) {
    extern __shared__ __attribute__((aligned(16))) unsigned char lds_raw[];
    Ctx C;
    C.lds = (LAS unsigned char*)lds_raw;
    C.tid = threadIdx.x; C.lane = C.tid & 63; C.wave = __builtin_amdgcn_readfirstlane(C.tid >> 6); C.G = gridDim.x; C.gw = blockIdx.x * 8 + C.wave; C.NGW = C.G * 8; C.dup = a.dup;
    C.x = a.in[0]; C.w_in = a.in[1]; C.c_norm = a.in[2]; C.w_uk = a.in[3]; C.w_uv = a.in[4]; C.rel_bias = a.in[5]; C.conv_w = a.in[6]; C.a_log = a.in[7]; C.dt_bias = a.in[8]; C.o_norm = a.in[9];
    C.w_out = a.in[10]; C.g_pre_mix = a.in[11]; C.g_post_mix = a.in[12]; C.g_pre_mlp = a.in[13]; C.g_post_mlp = a.in[14]; C.w_mi = a.in[15]; C.w_mo = a.in[16]; C.out = a.out;
    unsigned char* ws = a.ws;
    C.WinT = (bf16*)(ws + WS_WIN); C.WoutT = (bf16*)(ws + WS_WOUT); C.WmiT = (bf16*)(ws + WS_WMI); C.WmoT = (bf16*)(ws + WS_WMO); C.R1 = (bf16*)(ws + WS_R1); C.proj = (bf16*)(ws + WS_PROJ);
    C.cn = (bf16*)(ws + WS_CN); C.act = (bf16*)(ws + WS_ACT); C.small = (float*)(ws + WS_SMALL); C.mix = (float*)(ws + WS_MIX); C.y = (float*)(ws + WS_Y);
    C.gop = (unsigned char*)a.out; C.gU = ws + WS_GU; C.galast = (float*)(ws + WS_ALAST); C.og = (float*)(ws + WS_OG);
    volatile LAS unsigned* MISC = (volatile LAS unsigned*)(C.lds + MISC_OFF);
    if (C.tid < 16) MISC[C.tid] = 0u;
    __syncthreads();
    const int lo = a.ph_lo, hi = a.ph_hi;
    XcdBarrier bar; bar.bar = (unsigned*)(ws + WS_CTL) + CW_BAR; bar.x = 0; bar.st = nullptr;
    if (hi - lo > 1) bar = xcd_barrier_post((unsigned*)(ws + WS_CTL) + CW_BAR, MISC);
#ifndef DUP_MASK
#define DUP_MASK 0
#endif
#define REPS(k)
#define IN(k) (lo <= (k) && (k) < hi)
#ifdef PROBE_PA
    unsigned long long* tsw = (unsigned long long*)(ws + WS_CTL + 65536);
#define STAMP(k) do { if (blockIdx.x == 0 && C.tid == 0) tsw[(k)] = __builtin_amdgcn_s_memrealtime(); } while (0)
#else
#define STAMP(k) do { } while (0)
#endif
#define SEAM(k) do { if (IN(k) && IN((k) + 1)) xcd_barrier(bar); STAMP((k) + 1); } while (0)

#ifndef NO_P0
    STAMP(0);
    if (IN(0)) { REPS(0) p0_prologue(C); SEAM(0); }
#endif
#ifndef NO_GEMM
    if (IN(1)) { pg8::Gemm g{C.R1, C.WinT, MROWS, NPROJ, DM}; pg8::StaticOrder S; S.init(MROWS, NPROJ, C.G, (int)blockIdx.x);
        pg8::EpiProj E{C.proj, NPROJ, C.small};
        REPS(1) pg8::gemm_phase<pg8::EpiProj, pg8::StaticOrder, false>(C.lds, g, S, E, nullptr); SEAM(1); }
#endif
#ifdef GDN_NAIVE
    if (IN(2)) { p2_cn(C); if (blockIdx.x < 64) p2_gdn_seq(C, blockIdx.x >> 2, blockIdx.x & 3); SEAM(2); }
    if (IN(3)) { SEAM(3); }
#else
    if (IN(2)) { REPS(2) { p2_cn(C);
#ifndef G1OFF
 gdn::g1_phase(C);
#endif
 } SEAM(2); }
#ifndef G2OFF
    if (IN(3)) { REPS(3) if (C.G == 256) { const int x = blockIdx.x & 7, yy = blockIdx.x >> 3; gdn::g2_scan(C, x + 8 * (yy >> 2), yy & 3); }
                 else if (blockIdx.x < 256) gdn::g2_scan(C, blockIdx.x >> 2, blockIdx.x & 3);
                 SEAM(3); }
#endif
#endif
    if (IN(4)) { REPS(4) {
#ifndef GDN_NAIVE
        gdn::gnorm_phase(C);
#endif
#ifdef DSA_NAIVE
        p3_dsa(C);
#else
#ifndef DSAOFF
        dsa::p3_dsa_mfma(C);
#endif
#endif
        } SEAM(4); }
#ifndef NO_GEMM
    if (IN(5)) { pg8::Gemm g{C.R1, C.WoutT, MROWS, DM, KOUT}; pg8::StaticOrder S; S.init(MROWS, DM, C.G, (int)blockIdx.x);
        pg8::EpiF32 E{C.mix, DM, nullptr};
        pg8::gemm_phase<pg8::EpiF32, pg8::StaticOrder, false>(C.lds, g, S, E, nullptr); SEAM(5); }
#endif
    if (IN(6)) { REPS(6) p5_postnorm(C); SEAM(6); }
#ifndef NO_GEMM
    if (IN(7)) { pg8::Gemm g{C.R1, C.WmiT, MROWS, DFF, DM}; pg8::StaticOrder S; S.init(MROWS, DFF, C.G, (int)blockIdx.x);
        pg8::EpiRelu2 E{C.act, DFF};
        pg8::gemm_phase<pg8::EpiRelu2, pg8::StaticOrder, false>(C.lds, g, S, E, nullptr); SEAM(7); }
    if (IN(8)) { pg8::Gemm g{C.act, C.WmoT, MROWS, DM, DFF}; pg8::StaticOrder S; S.init(MROWS, DM, C.G, (int)blockIdx.x);
        pg8::EpiF32 E{C.y, DM, nullptr};
        pg8::gemm_phase<pg8::EpiF32, pg8::StaticOrder, false>(C.lds, g, S, E, nullptr); SEAM(8); }
#endif
    if (IN(9)) { p8_final(C); }
#ifdef PROBE_PA
    xcd_barrier(bar); STAMP(10); xcd_barrier(bar);
    { const float va = (float)(tsw[PROBE_PA + 1] - tsw[PROBE_PA]) * 0.01f, vb = (float)(tsw[PROBE_PB + 1] - tsw[PROBE_PB]);
      for (size_t i = (size_t)blockIdx.x * 512 + C.tid; i < (size_t)MROWS * DM; i += (size_t)C.G * 512) C.out[i] = (i == 0) ? vb : va; }
#endif
#undef IN
#undef SEAM
}

extern "C" void kernel_launch(void* const* d_in, const int* in_sizes, int n_in, void* d_out, int out_size, void* d_ws, size_t ws_size, hipStream_t stream) {
    static int grid = 0;
    if (grid == 0) {
        if (n_in != 17 || in_sizes[0] != MROWS * DM || out_size != MROWS * DM || ws_size < WS_END) {
            fprintf(stderr, "kernel_launch: built for 17 inputs, x/out of %d floats, >= %zu bytes of workspace; got n_in %d, in0 %d, out %d, ws %zu; nothing launched\n", MROWS * DM, (size_t)WS_END, n_in, n_in > 0 ? in_sizes[0] : -1, out_size, ws_size); grid = -1; return; }
        int dev = 0, cus = 0, per_cu = 0;
        if (hipGetDevice(&dev) != hipSuccess || hipDeviceGetAttribute(&cus, hipDeviceAttributeMultiprocessorCount, dev) != hipSuccess) { fprintf(stderr, "kernel_launch: device query failed\n"); grid = -1; return; }
        if (hipFuncSetAttribute((const void*)fwd, hipFuncAttributeMaxDynamicSharedMemorySize, LDS_BYTES) != hipSuccess) { fprintf(stderr, "kernel_launch: hipFuncSetAttribute failed\n"); grid = -1; return; }
        if (hipOccupancyMaxActiveBlocksPerMultiprocessor(&per_cu, (const void*)fwd, 512, LDS_BYTES) != hipSuccess || per_cu < 1)
            fprintf(stderr, "kernel_launch: note: occupancy query reports %d workgroups per CU\n", per_cu);
        (void)hipGetLastError();
        grid = cus;
        if (grid < 64) { fprintf(stderr, "kernel_launch: needs >= 64 CUs\n"); grid = -1; return; }
    }
    if (grid < 0) return;
    if (hipMemsetAsync((char*)d_ws + WS_CTL, 0, CTL_ZERO_BYTES, stream) != hipSuccess) { fprintf(stderr, "kernel_launch: memset failed\n"); return; }
    Args a{};
    for (int i = 0; i < 17; ++i) a.in[i] = (const float*)d_in[i];
    a.out = (float*)d_out; a.ws = (unsigned char*)d_ws; a.dup = DUP_MASK; a.pad = 0;
    if (MK_N_LAUNCHES == 1) { a.ph_lo = 0; a.ph_hi = NPHASE; hipLaunchKernelGGL(fwd, dim3(grid), dim3(512), LDS_BYTES, stream, a); }
    else for (int p = 0; p < NPHASE; ++p) { a.ph_lo = p; a.ph_hi = p + 1; hipLaunchKernelGGL(fwd, dim3(grid), dim3(512), LDS_BYTES, stream, a); }
    const hipError_t le = hipPeekAtLastError();
    if (le != hipSuccess) fprintf(stderr, "kernel_launch: launch failed: %s\n", hipGetErrorName(le));
}
```
